# Optimizing an MI355X kernel written in HIP

```python
import math
import jax, jax.numpy as jnp
from jax import lax
import numpy as np

D_MODEL = 1024
BATCH = 4
SEQ = 8192
DEPTH = 4

CHUNK = 64
N_PREV = 8
BAND = (N_PREV + 1) * CHUNK
N_HEADS = 16
HEAD_DIM = D_MODEL // N_HEADS
E_MIX = N_HEADS * HEAD_DIM
REL_CLIP = 128
N_REL = 2 * REL_CLIP + 1
CONV_W = 3
N_MEM = 256
MEM_HEADS = 4
MEM_HEAD_DIM = 128
E_MEM = MEM_HEADS * MEM_HEAD_DIM
E_BRANCH = E_MIX + E_MEM
N_IN = 3 * E_MIX + E_MEM + E_BRANCH
N_MIXERS = 2
N_ATTN_LAYERS = (DEPTH + 1) // 2
N_CONV_LAYERS = DEPTH // 2
DN_ALPHA = (2.0 * DEPTH) ** 0.25
DN_BETA = (8.0 * DEPTH) ** -0.25
LN_EPS = 1e-5

kernel_name = "hybrid_chunk_attn_shortconv_mem_deepnorm"


def layer_norm(x, g, b):
    xf = x.astype(jnp.float32)
    mu = jnp.mean(xf, axis=-1, keepdims=True)
    var = jnp.mean(jnp.square(xf - mu), axis=-1, keepdims=True)
    y = (xf - mu) * lax.rsqrt(var + LN_EPS) * g.astype(jnp.float32) + b.astype(jnp.float32)
    return y.astype(x.dtype)


def rel_bias_band(table):
    i = jnp.arange(CHUNK)[:, None]
    m = jnp.arange(BAND)[None, :]
    rel = N_PREV * CHUNK + i - m
    idx = jnp.clip(rel, -REL_CLIP, REL_CLIP) + REL_CLIP
    return table[:, idx]


def chunked_attention(q, k, v, bias_table):
    b, s, h, dh = q.shape
    n_chunks = s // CHUNK
    pad = ((0, 0), (N_PREV * CHUNK, 0), (0, 0), (0, 0))
    k_pad = jnp.pad(k, pad)
    v_pad = jnp.pad(v, pad)
    bias = rel_bias_band(bias_table).astype(jnp.float32)
    scale = 1.0 / math.sqrt(dh)
    q_blocks = jnp.moveaxis(q.reshape(b, n_chunks, CHUNK, h, dh), 1, 0)
    neg = jnp.finfo(jnp.float32).min

    def one_chunk(args):
        q_blk, c = args
        k_band = lax.dynamic_slice_in_dim(k_pad, c * CHUNK, BAND, axis=1)
        v_band = lax.dynamic_slice_in_dim(v_pad, c * CHUNK, BAND, axis=1)
        sc = jnp.einsum('bqhd,bkhd->bhqk', q_blk, k_band).astype(jnp.float32) * scale + bias[None]
        key_pos = (c - N_PREV) * CHUNK + jnp.arange(BAND)
        sc = jnp.where((key_pos >= 0)[None, None, None, :], sc, neg)
        p = jax.nn.softmax(sc, axis=-1).astype(v_band.dtype)
        return jnp.einsum('bhqk,bkhd->bqhd', p, v_band)

    out = lax.map(one_chunk, (q_blocks, jnp.arange(n_chunks)))
    return jnp.moveaxis(out, 0, 1).reshape(b, s, h * dh)


def causal_dwconv(u, w):
    c = u.shape[-1]
    return lax.conv_general_dilated(
        u, w[:, None, :].astype(u.dtype), window_strides=(1,),
        padding=[(CONV_W - 1, 0)], dimension_numbers=('NWC', 'WIO', 'NWC'),
        feature_group_count=c)


def short_gated_conv(bg, cg, u, w):
    return bg * causal_dwconv(cg * u, w)


def memory_attention(q_mem, kv_mem):
    b, s, _ = q_mem.shape
    q = q_mem.reshape(b, s, MEM_HEADS, MEM_HEAD_DIM)
    k, v = jnp.split(kv_mem, 2, axis=-1)
    k = k.reshape(b, -1, MEM_HEADS, MEM_HEAD_DIM)
    v = v.reshape(b, -1, MEM_HEADS, MEM_HEAD_DIM)
    sc = jnp.einsum('bshd,bmhd->bhsm', q, k).astype(jnp.float32) / math.sqrt(MEM_HEAD_DIM)
    p = jax.nn.softmax(sc, axis=-1).astype(v.dtype)
    return jnp.einsum('bhsm,bmhd->bshd', p, v).reshape(b, s, E_MEM)


def setup_inputs(seed: int = 0) -> dict:
    key = jax.random.key(seed)
    ks = jax.random.split(key, 10)
    x = jax.random.normal(ks[0], (BATCH, SEQ, D_MODEL), jnp.float32)
    mem = jax.random.normal(ks[1], (BATCH, N_MEM, D_MODEL), jnp.float32)
    w_in = jax.random.normal(ks[2], (DEPTH, D_MODEL, N_IN), jnp.float32) * D_MODEL ** -0.5
    w_mem_kv = jax.random.normal(ks[3], (DEPTH, D_MODEL, 2 * E_MEM), jnp.float32) * D_MODEL ** -0.5
    w_out = jax.random.normal(ks[4], (DEPTH, E_BRANCH, D_MODEL), jnp.float32) * (E_BRANCH ** -0.5 * DN_BETA)
    rel_bias = jax.random.normal(ks[5], (N_ATTN_LAYERS, N_HEADS, N_REL), jnp.float32) * 0.5
    conv_w = jax.random.normal(ks[6], (N_CONV_LAYERS, CONV_W, E_MIX), jnp.float32) * CONV_W ** -0.5
    ln_g = 1.0 + 0.05 * jax.random.normal(ks[7], (DEPTH, D_MODEL), jnp.float32)
    ln_b = 0.02 * jax.random.normal(ks[8], (DEPTH, D_MODEL), jnp.float32)
    return {"x": x, "mem": mem, "w_in": w_in, "w_mem_kv": w_mem_kv, "w_out": w_out,
            "rel_bias": rel_bias, "conv_w": conv_w, "ln_g": ln_g, "ln_b": ln_b}


def reference(x, mem, w_in, w_mem_kv, w_out, rel_bias, conv_w, ln_g, ln_b):
    b, s, _ = x.shape
    for layer in range(DEPTH):
        h = jnp.einsum('bsd,de->bse', x, w_in[layer])
        mix_in = h[..., :3 * E_MIX]
        q_mem = h[..., 3 * E_MIX:3 * E_MIX + E_MEM]
        z = h[..., 3 * E_MIX + E_MEM:]
        p0, p1, p2 = jnp.split(mix_in, 3, axis=-1)
        if layer % N_MIXERS == 0:
            q = p0.reshape(b, s, N_HEADS, HEAD_DIM)
            k = p1.reshape(b, s, N_HEADS, HEAD_DIM)
            v = p2.reshape(b, s, N_HEADS, HEAD_DIM)
            mix_out = chunked_attention(q, k, v, rel_bias[layer // N_MIXERS])
        else:
            mix_out = short_gated_conv(p0, p1, p2, conv_w[layer // N_MIXERS])
        kv_mem = jnp.einsum('bmd,de->bme', mem, w_mem_kv[layer])
        mem_out = memory_attention(q_mem, kv_mem)
        y = jnp.concatenate([mix_out, mem_out], axis=-1) * jax.nn.silu(z)
        out = jnp.einsum('bse,ed->bsd', y, w_out[layer])
        x = layer_norm(DN_ALPHA * x + out, ln_g[layer], ln_b[layer])
    return x
```

```cpp
#include <hip/hip_runtime.h>
#include <hip/hip_cooperative_groups.h>
#include <cstdio>
#include <cstdint>
namespace cg = cooperative_groups;
#ifndef MK_MULTI
#define MK_MULTI 0
#endif
namespace pg8 {
#define PG8_LAS __attribute__((address_space(3)))
typedef unsigned short bf16_t;
typedef short bf16x8 __attribute__((ext_vector_type(8)));
typedef float f32x4 __attribute__((ext_vector_type(4)));
typedef unsigned u32x4 __attribute__((ext_vector_type(4)));
constexpr int BM = 256, BK = 64, HALF = 128, HTB = HALF * BK * 2  , STAGE_BYTES = 8 * HTB, NXCD = 8, WGM = 8;

__host__ __device__ __forceinline__ int lds_byte(int r, int c) { const int st = (r >> 4) * 2 + (c >> 5), rr = r & 15, cc = c & 31, ob = rr * 64 + cc * 2; return st * 1024 + (ob ^ (((ob >> 9) & 1) << 5)); }
__host__ __device__ __forceinline__ void stage_rc(int b, int& R, int& C) { const int st = b / 1024, sb = b % 1024, swz = sb ^ (((sb >> 9) & 1) << 5); R = (st >> 1) * 16 + swz / 64; C = (st & 1) * 32 + (swz % 64) / 2; }
__host__ __device__ __forceinline__ int perm32(int rho) { const int n = rho >> 4, i = rho & 15; return 8 * (i >> 2) + 4 * n + (i & 3); }

struct Unit { int pm, pn; };

struct StaticOrder {
    int nM, nN, nwg, G, c;
    __host__ __device__ void init(int M, int N, int G_, int c_) { nM = M / BM; nN = N / BM; nwg = nM * nN; G = G_; c = c_; }
    __host__ __device__ bool next(int i, Unit& u) const {
        const long L = (long)i * G + c; if (L >= nwg) return false;
        int wgid = (int)L; { const int q = nwg / NXCD, r = nwg % NXCD, xcd = wgid % NXCD, off = wgid / NXCD; wgid = (xcd < r ? xcd * (q + 1) : r * (q + 1) + (xcd - r) * q) + off; }
        const int nig = WGM * nN, gid = wgid / nig, fm = gid * WGM, gsz = (nM - fm) < WGM ? (nM - fm) : WGM;
        u.pm = fm + ((wgid % nig) % gsz); u.pn = (wgid % nig) / gsz; return true;
    }
    __device__ __forceinline__ void a_ready(const Unit&) const {}
    __device__ __forceinline__ void done(const Unit&) const {}
};

struct Gemm { const bf16_t* A; const bf16_t* Bt; int M, N, K, lda; };
__device__ __forceinline__ unsigned cvt_pk_bf16(float lo, float hi) { unsigned r; asm volatile("v_cvt_pk_bf16_f32 %0, %1, %2" : "=v"(r) : "v"(lo), "v"(hi)); return r; }
typedef float f32x2 __attribute__((ext_vector_type(2)));
constexpr float LN_EPS = 1e-5f, INV_D = 1.0f / 1024.0f, DN_ALPHA = 1.681792830507429f;

struct EpiPlain {
    static constexpr bool PERM = true, AFTER_DRAIN = false;
    bf16_t* O; int ldc;
    __device__ __forceinline__ void operator()(const f32x4 (&acc)[2][2][4][2], const Unit& u, int wr, int wc, int fr, int fq) const {
        const int row0 = u.pm * BM + wr * 64 + fr, col0 = u.pn * BM + wc * 32 + 8 * fq;
#pragma unroll
        for (int ai = 0; ai < 2; ++ai)
#pragma unroll
            for (int m = 0; m < 4; ++m) { bf16_t* rowp = O + (size_t)(row0 + ai * HALF + m * 16) * ldc + col0;
#pragma unroll
                for (int bj = 0; bj < 2; ++bj) { const f32x4 v0 = acc[ai][bj][m][0], v1 = acc[ai][bj][m][1];
                    u32x4 w; w.x = cvt_pk_bf16(v0[0], v0[1]); w.y = cvt_pk_bf16(v0[2], v0[3]); w.z = cvt_pk_bf16(v1[0], v1[1]); w.w = cvt_pk_bf16(v1[2], v1[3]);
                    *(u32x4*)(rowp + bj * HALF) = w; } }
    }
};
struct EpiIn {
    static constexpr bool PERM = true, AFTER_DRAIN = false;
    bf16_t* O; int ldc; const float* stats; const float* cs; const float* bw;
    __device__ __forceinline__ void operator()(const f32x4 (&acc)[2][2][4][2], const Unit& u, int wr, int wc, int fr, int fq) const {
        const int row0 = u.pm * BM + wr * 64 + fr, col0 = u.pn * BM + wc * 32 + 8 * fq;
        f32x2 st[2][4];
#pragma unroll
        for (int ai = 0; ai < 2; ++ai)
#pragma unroll
            for (int m = 0; m < 4; ++m) st[ai][m] = *(const f32x2*)(stats + 2 * (size_t)(row0 + ai * HALF + m * 16));
        f32x4 c4[2][2], b4[2][2];
#pragma unroll
        for (int bj = 0; bj < 2; ++bj)
#pragma unroll
            for (int n = 0; n < 2; ++n) { c4[bj][n] = *(const f32x4*)(cs + col0 + bj * HALF + 4 * n); b4[bj][n] = *(const f32x4*)(bw + col0 + bj * HALF + 4 * n); }
#pragma unroll
        for (int ai = 0; ai < 2; ++ai)
#pragma unroll
            for (int m = 0; m < 4; ++m) { const int r = row0 + ai * HALF + m * 16;
                const float mu = st[ai][m].x * INV_D, var = st[ai][m].y * INV_D - mu * mu, rstd = rsqrtf(var + LN_EPS);
                bf16_t* rowp = O + (size_t)r * ldc + col0;
#pragma unroll
                for (int bj = 0; bj < 2; ++bj) { const f32x4 v0 = (acc[ai][bj][m][0] - c4[bj][0] * mu) * rstd + b4[bj][0], v1 = (acc[ai][bj][m][1] - c4[bj][1] * mu) * rstd + b4[bj][1];
                    u32x4 w; w.x = cvt_pk_bf16(v0[0], v0[1]); w.y = cvt_pk_bf16(v0[2], v0[3]); w.z = cvt_pk_bf16(v1[0], v1[1]); w.w = cvt_pk_bf16(v1[2], v1[3]);
                    *(u32x4*)(rowp + bj * HALF) = w; } }
    }
};
struct EpiOut {
    static constexpr bool PERM = true, AFTER_DRAIN = false;
    const float* srcf; float* dstf; bf16_t* xb; const float* st_old; float* st_new; const float* g; const float* b; int wbf;
    template <bool SRCF>
    __device__ __forceinline__ void body(const f32x4 (&acc)[2][2][4][2], const Unit& u, int wr, int wc, int fr, int fq) const {
        const int row0 = u.pm * BM + wr * 64 + fr, col0 = u.pn * BM + wc * 32 + 8 * fq;
        f32x2 st[2]; st[0] = *(const f32x2*)(st_old + 2 * (size_t)row0);
        f32x4 g4[2][2], b4[2][2];
#pragma unroll
        for (int bj = 0; bj < 2; ++bj)
#pragma unroll
            for (int n = 0; n < 2; ++n) { g4[bj][n] = g ? *(const f32x4*)(g + col0 + bj * HALF + 4 * n) : (f32x4){1.f, 1.f, 1.f, 1.f}; b4[bj][n] = b ? *(const f32x4*)(b + col0 + bj * HALF + 4 * n) : (f32x4){0.f, 0.f, 0.f, 0.f}; }
        f32x4 po[SRCF ? 1 : 2][2][SRCF ? 2 : 1];
#pragma unroll
        for (int bj = 0; bj < 2; ++bj) { if (!SRCF) po[0][bj][0] = *(const f32x4*)(xb + (size_t)row0 * 1024 + col0 + bj * HALF); }
#pragma unroll
        for (int i = 0; i < 8; ++i) { const int ai = i >> 2, m = i & 3; const int r = row0 + ai * HALF + m * 16;
            if (i < 7) { const int rn = row0 + ((i + 1) >> 2) * HALF + ((i + 1) & 3) * 16; st[(i + 1) & 1] = *(const f32x2*)(st_old + 2 * (size_t)rn);
#pragma unroll
                for (int bj = 0; bj < 2; ++bj) { if (!SRCF) po[SRCF ? 0 : ((i + 1) & 1)][bj][0] = *(const f32x4*)(xb + (size_t)rn * 1024 + col0 + bj * HALF); } }
            if (SRCF) {
#pragma unroll
                for (int bj = 0; bj < 2; ++bj) { po[0][bj][0] = *(const f32x4*)(srcf + (size_t)r * 1024 + col0 + bj * HALF); po[0][bj][SRCF ? 1 : 0] = *(const f32x4*)(srcf + (size_t)r * 1024 + col0 + bj * HALF + 4); } }
            asm volatile("" ::: "memory");
            const float mu = st[i & 1].x * INV_D, var = st[i & 1].y * INV_D - mu * mu, rstd = rsqrtf(var + LN_EPS);
            const size_t off = (size_t)r * 1024 + col0; float s = 0.f, q = 0.f;
#pragma unroll
            for (int bj = 0; bj < 2; ++bj) { f32x4 v[2];
#pragma unroll
                for (int n = 0; n < 2; ++n) { f32x4 pv;
                    if (SRCF) pv = po[0][bj][SRCF ? n : 0];
                    else { const u32x4 raw = __builtin_bit_cast(u32x4, po[SRCF ? 0 : (i & 1)][bj][0]); const unsigned w0 = raw[2 * n], w1 = raw[2 * n + 1];
                           pv = (f32x4){__builtin_bit_cast(float, w0 << 16), __builtin_bit_cast(float, w0 & 0xffff0000u), __builtin_bit_cast(float, w1 << 16), __builtin_bit_cast(float, w1 & 0xffff0000u)}; }
                    const f32x4 x = (pv - mu) * rstd * g4[bj][n] + b4[bj][n]; v[n] = x * DN_ALPHA + acc[ai][bj][m][n];
                    s += (v[n][0] + v[n][1]) + (v[n][2] + v[n][3]); q += (v[n][0] * v[n][0] + v[n][1] * v[n][1]) + (v[n][2] * v[n][2] + v[n][3] * v[n][3]); }
                if (dstf) { *(f32x4*)(dstf + off + bj * HALF) = v[0]; *(f32x4*)(dstf + off + bj * HALF + 4) = v[1]; }
                if (wbf) { u32x4 w; w.x = cvt_pk_bf16(v[0][0], v[0][1]); w.y = cvt_pk_bf16(v[0][2], v[0][3]); w.z = cvt_pk_bf16(v[1][0], v[1][1]); w.w = cvt_pk_bf16(v[1][2], v[1][3]);
                       *(u32x4*)(xb + off + bj * HALF) = w; } }
            s += __shfl_xor(s, 16); s += __shfl_xor(s, 32); q += __shfl_xor(q, 16); q += __shfl_xor(q, 32);
            if (fq == 0) { unsafeAtomicAdd(st_new + 2 * (size_t)r, s); unsafeAtomicAdd(st_new + 2 * (size_t)r + 1, q); }
            asm volatile("" ::: "memory"); }
    }
    __device__ __forceinline__ void operator()(const f32x4 (&acc)[2][2][4][2], const Unit& u, int wr, int wc, int fr, int fq) const {
        if (srcf) body<true>(acc, u, wr, wc, fr, fq); else body<false>(acc, u, wr, wc, fr, fq);
    }
};
template <class Epi, class Sched, bool ALIGN_EPI = false, bool SP2 = false>
__device__ __forceinline__ void gemm_phase(PG8_LAS unsigned char* lds, const Gemm g, const Sched& S, const Epi& E, const int tid) {
    const int wid = __builtin_amdgcn_readfirstlane(tid >> 6), lane = tid & 63, wr = wid >> 2, wc = wid & 3, fr = lane & 15, fq = lane >> 4;
    const int K = g.K, nt = K / BK;
    unsigned voffA[2], voffB[2];
#pragma unroll
    for (int i = 0; i < 2; ++i) { int R, C; stage_rc(tid * 16 + i * 8192, R, C); const int Rb = Epi::PERM ? ((R & ~31) + perm32(R & 31)) : R;
        voffA[i] = (unsigned)(R * g.lda + C) * 2u; voffB[i] = (unsigned)(Rb * K + C) * 2u; }
    const size_t kstep = (size_t)(BK * 2);
    const size_t hstep = (size_t)HALF * K * 2;
    const size_t tstep = 2 * hstep; const size_t hstepA = (size_t)HALF * g.lda * 2; const size_t tstepA = 2 * hstepA;
    const unsigned ldsw = (unsigned)wid * 1024u;
    const int aoff = lds_byte(wr * 64 + fr, fq * 8), boff = lds_byte(wc * 32 + fr, fq * 8);
#define PG8_SA(b, h) (((b) * 2 + (h)) * HTB)
#define PG8_SB(b, h) ((4 + (b) * 2 + (h)) * HTB)
#define PG8_STAGE(bufoff, gbase, voff) do { _Pragma("unroll") for (int _i = 0; _i < 2; ++_i) \
        __builtin_amdgcn_global_load_lds((const unsigned*)((const char*)(gbase) + (voff)[_i]), (PG8_LAS unsigned*)(lds + (bufoff) + ldsw + _i * 8192), 16, 0, 0); } while (0)
#define PG8_LDA(dst, b, h) do { _Pragma("unroll") for (int m = 0; m < 4; ++m) _Pragma("unroll") for (int k = 0; k < 2; ++k) dst[m][k] = *(const PG8_LAS bf16x8*)(lds + PG8_SA(b, h) + aoff + m * 2048 + k * 1024); } while (0)
#define PG8_LDB(dst, b, h) do { _Pragma("unroll") for (int n = 0; n < 2; ++n) _Pragma("unroll") for (int k = 0; k < 2; ++k) dst[n][k] = *(const PG8_LAS bf16x8*)(lds + PG8_SB(b, h) + boff + n * 2048 + k * 1024); } while (0)
#define PG8_MMA(ai, bj, At, Bt) do { __builtin_amdgcn_s_setprio(1); _Pragma("unroll") for (int m = 0; m < 4; ++m) _Pragma("unroll") for (int n = 0; n < 2; ++n) _Pragma("unroll") for (int k = 0; k < 2; ++k) \
        acc[ai][bj][m][n] = __builtin_amdgcn_mfma_f32_16x16x32_bf16(Bt[n][k], At[m][k], acc[ai][bj][m][n], 0, 0, 0); __builtin_amdgcn_s_setprio(0); } while (0)
#define PG8_WAIT_V(n) asm volatile("s_waitcnt vmcnt(" #n ")" ::: "memory")
#define PG8_WAIT_L(n) asm volatile("s_waitcnt lgkmcnt(" #n ")" ::: "memory")
#define PG8_BAR __builtin_amdgcn_s_barrier()
#define PG8_SCHED __builtin_amdgcn_sched_barrier(0)
    Unit cur, nxt; int ui = 0;
    if (!S.next(0, cur)) return;
    f32x4 acc[2][2][4][2];
#pragma unroll
    for (int a = 0; a < 2; ++a)
#pragma unroll
        for (int b = 0; b < 2; ++b)
#pragma unroll
            for (int m = 0; m < 4; ++m)
#pragma unroll
                for (int n = 0; n < 2; ++n) acc[a][b][m][n] = (f32x4){0.f, 0.f, 0.f, 0.f};
    bf16x8 At[4][2], B0[2][2], B1[2][2];
    const char* cA = (const char*)g.A + (size_t)cur.pm * tstepA; const char* cB = (const char*)g.Bt + (size_t)cur.pn * tstep;
    S.a_ready(cur);
    if constexpr (SP2) {
        PG8_STAGE(PG8_SB(0, 0), cB, voffB); PG8_STAGE(PG8_SB(0, 1), cB + hstep, voffB); PG8_STAGE(PG8_SA(0, 0), cA, voffA); PG8_STAGE(PG8_SA(0, 1), cA + hstepA, voffA);
        if (wr == 1) PG8_BAR;
        PG8_WAIT_V(2); PG8_BAR;
        PG8_STAGE(PG8_SB(1, 0), cB + kstep, voffB); PG8_STAGE(PG8_SA(1, 0), cA + kstep, voffA); PG8_STAGE(PG8_SB(1, 1), cB + hstep + kstep, voffB);
        PG8_WAIT_V(6); PG8_BAR;
    } else {
        PG8_STAGE(PG8_SB(0, 0), cB, voffB); PG8_STAGE(PG8_SA(0, 0), cA, voffA); PG8_STAGE(PG8_SB(0, 1), cB + hstep, voffB); PG8_STAGE(PG8_SA(0, 1), cA + hstepA, voffA);
        if (wr == 1) PG8_BAR;
        PG8_WAIT_V(4); PG8_BAR;
        PG8_STAGE(PG8_SB(1, 0), cB + kstep, voffB); PG8_STAGE(PG8_SA(1, 0), cA + kstep, voffA); PG8_STAGE(PG8_SB(1, 1), cB + hstep + kstep, voffB);
        PG8_WAIT_V(6); PG8_BAR;
    }
    for (;;) {
        const bool has_next = S.next(ui + 1, nxt);
        const char* nA = has_next ? (const char*)g.A + (size_t)nxt.pm * tstepA : cA; const char* nB = has_next ? (const char*)g.Bt + (size_t)nxt.pn * tstep : cB;
        for (int t = 0; t < nt; t += 2) {
            const bool last = (t == nt - 2);
            const char* a1 = cA + (size_t)(t + 1) * kstep;
            const char* a2 = last ? nA : cA + (size_t)(t + 2) * kstep; const char* b2 = last ? nB : cB + (size_t)(t + 2) * kstep;
            const char* a3 = a2 + kstep; const char* b3 = b2 + kstep;
            if (last && has_next) S.a_ready(nxt);
            if constexpr (SP2) {
            PG8_LDB(B0, 0, 0); PG8_LDB(B1, 0, 1); PG8_SCHED; PG8_LDA(At, 0, 0); PG8_STAGE(PG8_SA(1, 1), a1 + hstepA, voffA);
            PG8_WAIT_V(8); PG8_WAIT_L(0); PG8_BAR; PG8_MMA(0, 0, At, B0); PG8_MMA(0, 1, At, B1); PG8_BAR; PG8_SCHED;
            PG8_LDA(At, 0, 1); PG8_STAGE(PG8_SB(0, 0), b2, voffB); PG8_STAGE(PG8_SB(0, 1), b2 + hstep, voffB); PG8_STAGE(PG8_SA(0, 0), a2, voffA);
            PG8_WAIT_V(8); PG8_WAIT_L(0); PG8_BAR; PG8_MMA(1, 0, At, B0); PG8_MMA(1, 1, At, B1); PG8_BAR; PG8_SCHED;
            PG8_LDB(B0, 1, 0); PG8_LDB(B1, 1, 1); PG8_SCHED; PG8_LDA(At, 1, 0); PG8_STAGE(PG8_SA(0, 1), a2 + hstepA, voffA);
            PG8_WAIT_V(8); PG8_WAIT_L(0); PG8_BAR; PG8_MMA(0, 0, At, B0); PG8_MMA(0, 1, At, B1); PG8_BAR; PG8_SCHED;
            PG8_LDA(At, 1, 1); PG8_STAGE(PG8_SB(1, 0), b3, voffB); PG8_STAGE(PG8_SB(1, 1), b3 + hstep, voffB); PG8_STAGE(PG8_SA(1, 0), a3, voffA);
            PG8_WAIT_V(8); PG8_WAIT_L(0); PG8_BAR; PG8_MMA(1, 0, At, B0); PG8_MMA(1, 1, At, B1); PG8_BAR; PG8_SCHED;
            } else {
            PG8_LDB(B0, 0, 0); PG8_SCHED; PG8_LDA(At, 0, 0); PG8_STAGE(PG8_SA(1, 1), a1 + hstepA, voffA);
            PG8_WAIT_L(8); PG8_BAR; PG8_WAIT_L(0); PG8_MMA(0, 0, At, B0); PG8_BAR; PG8_SCHED;
            PG8_LDB(B1, 0, 1); PG8_STAGE(PG8_SB(0, 0), b2, voffB);
            PG8_BAR; PG8_WAIT_L(0); PG8_MMA(0, 1, At, B1); PG8_BAR;
            PG8_LDA(At, 0, 1); PG8_STAGE(PG8_SA(0, 0), a2, voffA);
            PG8_BAR; PG8_WAIT_L(0); PG8_MMA(1, 0, At, B0); PG8_BAR; PG8_SCHED;
            PG8_STAGE(PG8_SB(0, 1), b2 + hstep, voffB);
            PG8_WAIT_V(6); PG8_BAR; PG8_MMA(1, 1, At, B1); PG8_BAR;
            PG8_LDB(B0, 1, 0); PG8_SCHED; PG8_LDA(At, 1, 0); PG8_STAGE(PG8_SA(0, 1), a2 + hstepA, voffA);
            PG8_WAIT_L(8); PG8_BAR; PG8_WAIT_L(0); PG8_MMA(0, 0, At, B0); PG8_BAR; PG8_SCHED;
            PG8_LDB(B1, 1, 1); PG8_STAGE(PG8_SB(1, 0), b3, voffB);
            PG8_BAR; PG8_WAIT_L(0); PG8_MMA(0, 1, At, B1); PG8_BAR;
            PG8_LDA(At, 1, 1); PG8_STAGE(PG8_SA(1, 0), a3, voffA);
            PG8_BAR; PG8_WAIT_L(0); PG8_MMA(1, 0, At, B0); PG8_BAR; PG8_SCHED;
            PG8_STAGE(PG8_SB(1, 1), b3 + hstep, voffB);
            PG8_WAIT_V(6); PG8_BAR; PG8_MMA(1, 1, At, B1); PG8_BAR;
            }
        }
        if constexpr (ALIGN_EPI) { if (wr == 0) PG8_BAR; }
        if constexpr (!Epi::AFTER_DRAIN) { E(acc, cur, wr, wc, fr, fq); S.done(cur); }
        if (!has_next) break;
#pragma unroll
        for (int a = 0; a < 2; ++a)
#pragma unroll
            for (int b = 0; b < 2; ++b)
#pragma unroll
                for (int m = 0; m < 4; ++m)
#pragma unroll
                    for (int n = 0; n < 2; ++n) acc[a][b][m][n] = (f32x4){0.f, 0.f, 0.f, 0.f};
        cur = nxt; cA = nA; cB = nB; ++ui;
        if constexpr (ALIGN_EPI) { if (wr == 1) PG8_BAR; }
    }
    PG8_WAIT_V(0);
    if constexpr (!ALIGN_EPI) { if (wr == 0) PG8_BAR; }
    PG8_BAR;
    if constexpr (Epi::AFTER_DRAIN) { E.fused(acc, cur, wr, wc, fr, fq, lds, wid, lane); S.done(cur); }
#undef PG8_SA
#undef PG8_SB
#undef PG8_STAGE
#undef PG8_LDA
#undef PG8_LDB
#undef PG8_MMA
#undef PG8_WAIT_V
#undef PG8_WAIT_L
#undef PG8_BAR
#undef PG8_SCHED
}
}
#define LAS __attribute__((address_space(3)))
typedef unsigned short bf16_t;
typedef short bf16x8 __attribute__((ext_vector_type(8)));
typedef float f32x4 __attribute__((ext_vector_type(4)));
typedef float f32x2 __attribute__((ext_vector_type(2)));
typedef float f32x16 __attribute__((ext_vector_type(16)));
typedef unsigned u32x4 __attribute__((ext_vector_type(4)));
typedef unsigned u32x2 __attribute__((ext_vector_type(2)));

constexpr int D = 1024, BATCH = 4, SEQ = 8192, M = BATCH * SEQ, DEPTH = 4, NCHUNK = SEQ / 64;
constexpr int HP = 5120;
constexpr int QOFF = 0, QMOFF = 1024, KOFF = 1536, VOFF = 2560, ZOFF = 3584;
constexpr int EB = 1536;
constexpr int NWAVES = 8;
constexpr float LOG2E = 1.4426950408889634f;
constexpr float LN_EPS = 1e-5f, INV_D = 1.0f / 1024.0f;
constexpr size_t MiB = 1u << 20;
constexpr size_t WS_CS = 0, WS_BW = 128 * 1024, WS_STATS = 256 * 1024, CTL_BYTES = 2 * MiB;
constexpr size_t WS_WIN = 2 * MiB, WS_WOUT = 42 * MiB, WS_WKV = 54 * MiB, WS_MEMB = 62 * MiB, WS_KVMEM = 64 * MiB, WS_XB = 72 * MiB, WS_H = 136 * MiB, WS_END = 456 * MiB;
static_assert(WS_STATS + (size_t)5 * M * 8 <= CTL_BYTES, "ctl");
constexpr int LDS_BYTES = 160000;
constexpr int LDS_BAR = 159744;
constexpr size_t WS_QCTR = 1700 * 1024;
constexpr size_t WS_BAR = 1536 * 1024;
constexpr int WAVE_LDS = 19488;
constexpr int VPITCH = 144;

__device__ __forceinline__ unsigned f2bf(float f) { unsigned u = __builtin_bit_cast(unsigned, f); return (u + 0x7fffu + ((u >> 16) & 1u)) >> 16; }
__device__ __forceinline__ unsigned pk2(float lo, float hi) { return f2bf(lo) | (f2bf(hi) << 16); }
__device__ __forceinline__ float bfr(float f) { return __builtin_bit_cast(float, f2bf(f) << 16); }
__device__ __forceinline__ float bflo(unsigned w) { return __builtin_bit_cast(float, w << 16); }
__device__ __forceinline__ float bfhi(unsigned w) { return __builtin_bit_cast(float, w & 0xffff0000u); }
__device__ __forceinline__ float silu(float z) { return z * __builtin_amdgcn_rcpf(1.0f + __builtin_amdgcn_exp2f(-z * LOG2E)); }
#define LDS_WAIT() asm volatile("s_waitcnt lgkmcnt(0)" ::: "memory")
__device__ __forceinline__ int lane_now() { int l; asm volatile("v_mbcnt_lo_u32_b32 %0, -1, 0\n\tv_mbcnt_hi_u32_b32 %0, -1, %0" : "=v"(l)); return l; }

struct TItem { const float* W; bf16_t* WT; const float* gv; const float* bv; float* cs; float* bw; int K, N, drow, k0, n0, scale; };
__device__ __forceinline__ void ti_load(const TItem& t, int lane, float (&w)[32]) {
#pragma unroll
    for (int i = 0; i < 32; ++i) { const int kk = 2 * i + (lane >> 5); w[i] = t.W[(size_t)(t.k0 + kk) * t.N + t.n0 + (lane & 31)]; }
}
__device__ __forceinline__ void ti_process(const TItem& t, LAS float* scr, int lane, const float (&wv)[32]) {
    float csp = 0.f, bwp = 0.f;
    if (t.scale) {
#pragma unroll
        for (int i = 0; i < 32; ++i) { const int kk = 2 * i + (lane >> 5); float w = wv[i]; const float gk = t.gv ? t.gv[t.k0 + kk] : 1.f, bk = t.bv ? t.bv[t.k0 + kk] : 0.f; bwp += w * bk; w *= gk; csp += bfr(w); scr[kk * 33 + (lane & 31)] = w; }
    } else {
#pragma unroll
        for (int i = 0; i < 32; ++i) { const int kk = 2 * i + (lane >> 5); scr[kk * 33 + (lane & 31)] = wv[i]; }
    }
    LDS_WAIT();
    const int c = lane & 7;
#pragma unroll
    for (int j = 0; j < 4; ++j) { const int n = (lane >> 3) + 8 * j; const LAS float* s = scr + (8 * c) * 33 + n;
        u32x4 o; o.x = pk2(s[0 * 33], s[1 * 33]); o.y = pk2(s[2 * 33], s[3 * 33]); o.z = pk2(s[4 * 33], s[5 * 33]); o.w = pk2(s[6 * 33], s[7 * 33]);
        *(u32x4*)(t.WT + (size_t)(t.drow + n) * t.K + t.k0 + 8 * c) = o; }
    LDS_WAIT();
    if (t.scale) { csp += __shfl_xor(csp, 32); bwp += __shfl_xor(bwp, 32);
        if (lane < 32) { unsafeAtomicAdd(t.cs + t.drow + lane, csp); unsafeAtomicAdd(t.bw + t.drow + lane, bwp); } }
}
__device__ __forceinline__ void row_to_bf16(const float* xrow, bf16_t* orow, int lane) {
    const f32x4* xr = (const f32x4*)xrow + lane; u32x2* o8 = (u32x2*)orow + lane;
#pragma unroll
    for (int j = 0; j < 4; ++j) { const f32x4 v = xr[64 * j]; u32x2 w; w.x = pk2(v[0], v[1]); w.y = pk2(v[2], v[3]); o8[64 * j] = w; }
}

struct Args { const float *x, *mem, *w_in, *w_kv, *w_out, *rel, *convw, *lng, *lnb; float* out; unsigned char* ws; int ph_lo, ph_hi; };

__device__ __forceinline__ void prologue(const Args& a, unsigned char* ws, LAS unsigned char* lds, int gw, int NGW, int wave, int lane) {
    LAS float* scr = (LAS float*)(lds + wave * WAVE_LDS);
    constexpr int I_IN = 16 * 160, I_OUT = 24 * 32, I_KV = 16 * 32;
    constexpr int NITEMS = DEPTH * (I_IN + I_OUT + I_KV);
    auto decode = [&](int it, TItem& t) {
        int r = it;
        if (r < DEPTH * I_IN) { const int l = r / I_IN, q = r % I_IN, kb = q / 160, nb = q % 160, n0 = nb * 32;
            const int dn = n0 < 1024 ? n0 : (n0 < 3072 ? n0 + 512 : (n0 < 3584 ? n0 - 2048 : n0));
            t.W = a.w_in + (size_t)l * D * HP; t.K = D; t.N = HP; t.WT = (bf16_t*)(ws + WS_WIN) + (size_t)l * HP * D; t.drow = dn; t.k0 = kb * 64; t.n0 = n0;
            t.gv = l ? a.lng + (l - 1) * D : nullptr; t.bv = l ? a.lnb + (l - 1) * D : nullptr; t.cs = (float*)(ws + WS_CS) + l * HP; t.bw = (float*)(ws + WS_BW) + l * HP; t.scale = 1; return; }
        r -= DEPTH * I_IN; t.gv = nullptr; t.bv = nullptr; t.cs = nullptr; t.bw = nullptr; t.scale = 0;
        if (r < DEPTH * I_OUT) { const int l = r / I_OUT, q = r % I_OUT, kb = q / 32, nb = q % 32;
            t.W = a.w_out + (size_t)l * EB * D; t.K = EB; t.N = D; t.WT = (bf16_t*)(ws + WS_WOUT) + (size_t)l * D * EB; t.drow = nb * 32; t.k0 = kb * 64; t.n0 = nb * 32; return; }
        r -= DEPTH * I_OUT;
        { const int l = r / I_KV, q = r % I_KV, kb = q / 32, nb = q % 32;
            t.W = a.w_kv + (size_t)l * D * D; t.K = D; t.N = D; t.WT = (bf16_t*)(ws + WS_WKV) + (size_t)l * D * D; t.drow = nb * 32; t.k0 = kb * 64; t.n0 = nb * 32; }
    };
    if (gw < NITEMS) {
        TItem cur; decode(gw, cur); float wc[32]; ti_load(cur, lane, wc);
        for (int it = gw; it < NITEMS; it += NGW) {
            TItem nxt = cur; float wn[32]; const bool more = it + NGW < NITEMS;
            if (more) { decode(it + NGW, nxt); ti_load(nxt, lane, wn); }
            ti_process(cur, scr, lane, wc);
            if (more) { cur = nxt;
#pragma unroll
                for (int i = 0; i < 32; ++i) wc[i] = wn[i]; }
        }
    }
    lane = lane_now();
    float* st0 = (float*)(ws + WS_STATS);
    for (int m = gw; m < M; m += 4 * NGW) {
        f32x4 v[4][4];
#pragma unroll
        for (int r = 0; r < 4; ++r)
#pragma unroll
            for (int j = 0; j < 4; ++j) v[r][j] = ((const f32x4*)(a.x + (size_t)(m + r * NGW) * D))[64 * j + lane];
#pragma unroll
        for (int r = 0; r < 4; ++r) { u32x2* o8 = (u32x2*)((bf16_t*)(ws + WS_XB) + (size_t)(m + r * NGW) * D) + lane;
#pragma unroll
            for (int j = 0; j < 4; ++j) { u32x2 w; w.x = pk2(v[r][j][0], v[r][j][1]); w.y = pk2(v[r][j][2], v[r][j][3]); o8[64 * j] = w; }
            if (lane == 0) { float c0 = 0.f, c1 = 1024.0f * (1.0f - LN_EPS); asm volatile("" : "+v"(c0), "+v"(c1));
                st0[2 * (size_t)(m + r * NGW)] = c0; st0[2 * (size_t)(m + r * NGW) + 1] = c1; } }
    }
    for (int m = gw; m < BATCH * 256; m += NGW) row_to_bf16(a.mem + (size_t)m * D, (bf16_t*)(ws + WS_MEMB) + (size_t)m * D, lane);
}

typedef short s16x4 __attribute__((ext_vector_type(4)));
typedef __bf16 bf2_t __attribute__((ext_vector_type(2)));
__device__ __forceinline__ unsigned cvtpk(float lo, float hi) { const f32x2 v = {lo, hi}; return __builtin_bit_cast(unsigned, __builtin_convertvector(v, bf2_t)); }
template <int DH, int KEYS, int NQ, bool BIAS, bool STAGE = true>
__device__ __forceinline__ void attn_task(const bf16_t* qbase, const bf16_t* kbase, const bf16_t* vbase, const bf16_t* zbase, bf16_t* ybase,
                                          int ldq, int ldkv, int ntiles, int jrot, int rel00, float scale, LAS unsigned char* kbuf, LAS unsigned char* vbuf, const LAS float* tab, int lane) {
    const int n = lane & 31, hh = lane >> 5;
    constexpr int KS = DH / 16, DB = DH / 32, PITCH = DH * 2 + 16, CPR = DH / 8  , RPI = 64 / CPR  , NP = KEYS / RPI;
    static_assert(KEYS == 32, "one 32-key row block per tile");
    const unsigned g0 = (unsigned)((lane / CPR) * ldkv + (lane % CPR) * 8), l0 = (unsigned)((lane / CPR) * PITCH + (lane % CPR) * 16);
    u32x4 kr[STAGE ? NP : 1], vr[STAGE ? NP : 1];
    if constexpr (STAGE) { const bf16_t* kt = kbase + (size_t)jrot * KEYS * ldkv; const bf16_t* vt = vbase + (size_t)jrot * KEYS * ldkv;
#pragma unroll
    for (int it = 0; it < NP; ++it) { kr[it] = *(const u32x4*)(kt + (size_t)it * RPI * ldkv + g0); vr[it] = *(const u32x4*)(vt + (size_t)it * RPI * ldkv + g0); } }
    bf16x8 qf[NQ][KS];
#pragma unroll
    for (int cq = 0; cq < NQ; ++cq)
#pragma unroll
        for (int ks = 0; ks < KS; ++ks) qf[cq][ks] = *(const bf16x8*)(qbase + (size_t)(32 * cq + n) * ldq + ks * 16 + hh * 8);
    f32x16 O[NQ][DB];
#pragma unroll
    for (int cq = 0; cq < NQ; ++cq)
#pragma unroll
        for (int d = 0; d < DB; ++d)
#pragma unroll
            for (int i = 0; i < 16; ++i) O[cq][d][i] = 0.f;
    float mrun[NQ], lsum[NQ];
#pragma unroll
    for (int cq = 0; cq < NQ; ++cq) { mrun[cq] = -1e30f; lsum[cq] = 0.f; }
    if constexpr (STAGE) { LDS_WAIT();
#pragma unroll
    for (int it = 0; it < NP; ++it) { *(LAS u32x4*)(kbuf + l0 + it * RPI * PITCH) = kr[it]; *(LAS u32x4*)(vbuf + l0 + it * RPI * PITCH) = vr[it]; } }
    const LAS unsigned char* kl0 = kbuf + n * PITCH + hh * 16;
    const LAS unsigned char* vl0 = vbuf + (4 * hh + ((lane & 15) >> 2)) * PITCH + (16 * ((lane >> 4) & 1) + 4 * (lane & 3)) * 2;
    __builtin_amdgcn_s_waitcnt(0x0F70);
    int j = jrot;
    for (int st = 0; st < ntiles; ++st) {
        const bool more = st + 1 < ntiles; const int jn = (j + 1 == ntiles) ? 0 : j + 1;
        const LAS unsigned char* kl = STAGE ? kl0 : kl0 + j * KEYS * PITCH; const LAS unsigned char* vl = STAGE ? vl0 : vl0 + j * KEYS * PITCH;
        if (STAGE && more) { const bf16_t* kt = kbase + (size_t)jn * KEYS * ldkv; const bf16_t* vt = vbase + (size_t)jn * KEYS * ldkv;
#pragma unroll
            for (int it = 0; it < NP; ++it) { kr[it] = *(const u32x4*)(kt + (size_t)it * RPI * ldkv + g0); vr[it] = *(const u32x4*)(vt + (size_t)it * RPI * ldkv + g0); } }
        bf16x8 kf[KS];
#pragma unroll
        for (int ks = 0; ks < KS; ++ks) kf[ks] = *(const LAS bf16x8*)(kl + ks * 32);
        union { bf16x8 v; s16x4 h[2]; } vf[2][DB];
        constexpr bool EARLY_V = (DH == 64);
#define ATT_LOAD_VF() _Pragma("unroll") for (int s = 0; s < 2; ++s) _Pragma("unroll") for (int d = 0; d < DB; ++d) { \
                vf[s][d].h[0] = __builtin_amdgcn_ds_read_tr16_b64_v4i16((LAS s16x4*)(vl + (16 * s) * PITCH + d * 64)); \
                vf[s][d].h[1] = __builtin_amdgcn_ds_read_tr16_b64_v4i16((LAS s16x4*)(vl + (16 * s + 8) * PITCH + d * 64)); }
        if (EARLY_V) { ATT_LOAD_VF() }
        const int rel0 = rel00 - j * KEYS;
        const bool elementwise = BIAS && rel0 < 160; const float bc = (BIAS && !elementwise) ? tab[0] : 0.f;
        f32x16 SS[NQ];
#pragma unroll
        for (int cq = 0; cq < NQ; ++cq)
#pragma unroll
            for (int i = 0; i < 16; ++i) SS[cq][i] = 0.f;
#pragma unroll
        for (int ks = 0; ks < KS; ++ks)
#pragma unroll
            for (int cq = 0; cq < NQ; ++cq) SS[cq] = __builtin_amdgcn_mfma_f32_32x32x16_bf16(kf[ks], qf[cq][ks], SS[cq], 0, 0, 0);
#pragma unroll
        for (int cq = 0; cq < NQ; ++cq) {
            f32x16 S = SS[cq];
            if (BIAS && elementwise) { const LAS float* tp = tab + (191 - rel0 - 32 * cq - n + 4 * hh);
#pragma unroll
                for (int i = 0; i < 16; ++i) S[i] = S[i] * scale + tp[(i & 3) + 8 * (i >> 2)]; }
            float mx = S[0];
#pragma unroll
            for (int i = 1; i < 16; ++i) mx = fmaxf(mx, S[i]);
            mx = fmaxf(mx, __shfl_xor(mx, 32));
            if (!elementwise) mx = mx * scale + bc;
            const bool grew = mx > mrun[cq] + 8.0f; const float mnew = grew ? mx : mrun[cq], alpha = __builtin_amdgcn_exp2f(mrun[cq] - mnew);
            mrun[cq] = mnew;
            float ps = 0.f;
            if (elementwise) {
#pragma unroll
                for (int i = 0; i < 16; ++i) { S[i] = __builtin_amdgcn_exp2f(S[i] - mnew); ps += S[i]; }
            } else { const float cc = bc - mnew;
#pragma unroll
                for (int i = 0; i < 16; ++i) { S[i] = __builtin_amdgcn_exp2f(S[i] * scale + cc); ps += S[i]; }
            }
            lsum[cq] = lsum[cq] * alpha + ps;
            if (__builtin_amdgcn_ballot_w64(grew) != 0ull) {
#pragma unroll
                for (int d = 0; d < DB; ++d)
#pragma unroll
                    for (int i = 0; i < 16; ++i) O[cq][d][i] *= alpha;
            }
            union { bf16x8 v; unsigned u[4]; } pf[2];
#pragma unroll
            for (int e = 0; e < 4; ++e) { pf[0].u[e] = cvtpk(S[2 * e], S[2 * e + 1]); pf[1].u[e] = cvtpk(S[8 + 2 * e], S[9 + 2 * e]); }
            if (!EARLY_V) { ATT_LOAD_VF() }
#pragma unroll
            for (int s = 0; s < 2; ++s)
#pragma unroll
                for (int d = 0; d < DB; ++d) O[cq][d] = __builtin_amdgcn_mfma_f32_32x32x16_bf16(vf[s][d].v, pf[s].v, O[cq][d], 0, 0, 0);
        }
        if (STAGE && more) {
            LDS_WAIT();
#pragma unroll
            for (int it = 0; it < NP; ++it) { *(LAS u32x4*)(kbuf + l0 + it * RPI * PITCH) = kr[it]; *(LAS u32x4*)(vbuf + l0 + it * RPI * PITCH) = vr[it]; }
        }
        j = jn;
    }
    float inv[NQ];
#pragma unroll
    for (int cq = 0; cq < NQ; ++cq) inv[cq] = 1.0f / (lsum[cq] + __shfl_xor(lsum[cq], 32));
    if constexpr (STAGE) {
        constexpr int OP = DH * 4 + 16, ROWS = 32 * NQ, NIT = ROWS * DH / 8 / 64, CPRO = DH / 8;
        static_assert(ROWS * OP <= 18432, "O tile fits the wave's K+V buffers");
        LDS_WAIT();
#pragma unroll
        for (int cq = 0; cq < NQ; ++cq)
#pragma unroll
            for (int d = 0; d < DB; ++d)
#pragma unroll
                for (int g4 = 0; g4 < 4; ++g4) { const f32x4 v = {O[cq][d][4 * g4] * inv[cq], O[cq][d][4 * g4 + 1] * inv[cq], O[cq][d][4 * g4 + 2] * inv[cq], O[cq][d][4 * g4 + 3] * inv[cq]};
                    *(LAS f32x4*)(kbuf + (32 * cq + n) * OP + (32 * d + 8 * g4 + 4 * hh) * 4) = v; }
        LDS_WAIT();
#pragma unroll
        for (int hb = 0; hb < NIT; hb += 4) { u32x4 zz[4];
#pragma unroll
        for (int it = 0; it < 4; ++it) { const int id = (hb + it) * 64 + lane, row = id / CPRO, chn = id % CPRO; zz[it] = *(const u32x4*)(zbase + (size_t)row * ldq + chn * 8); }
#pragma unroll
        for (int it = hb; it < hb + 4; ++it) { const int id = it * 64 + lane, row = id / CPRO, chn = id % CPRO;
            const f32x4 o0 = *(const LAS f32x4*)(kbuf + row * OP + chn * 32), o1 = *(const LAS f32x4*)(kbuf + row * OP + chn * 32 + 16); const u32x4 z = zz[it - hb];
            u32x4 w; w.x = cvtpk(o0[0] * silu(bflo(z.x)), o0[1] * silu(bfhi(z.x))); w.y = cvtpk(o0[2] * silu(bflo(z.y)), o0[3] * silu(bfhi(z.y)));
                     w.z = cvtpk(o1[0] * silu(bflo(z.z)), o1[1] * silu(bfhi(z.z))); w.w = cvtpk(o1[2] * silu(bflo(z.w)), o1[3] * silu(bfhi(z.w)));
            *(u32x4*)(ybase + (size_t)row * ldq + chn * 8) = w; } }
        LDS_WAIT();
    } else {
        static_assert(NQ == 1 && !BIAS, "non-staged form: one query block, no bias table"); LAS unsigned char* otb = (LAS unsigned char*)tab;
#pragma unroll
        for (int d = 0; d < DB; ++d) {
            u32x4 zz[2];
#pragma unroll
            for (int i2 = 0; i2 < 2; ++i2) { const int row = i2 * 16 + (lane >> 2), chn = lane & 3; zz[i2] = *(const u32x4*)(zbase + (size_t)row * ldq + 32 * d + chn * 8); }
            LDS_WAIT();
#pragma unroll
            for (int g4 = 0; g4 < 4; ++g4) { u32x2 w; w.x = cvtpk(O[0][d][4 * g4] * inv[0], O[0][d][4 * g4 + 1] * inv[0]); w.y = cvtpk(O[0][d][4 * g4 + 2] * inv[0], O[0][d][4 * g4 + 3] * inv[0]);
                *(LAS u32x2*)(otb + n * 80 + (8 * g4 + 4 * hh) * 2) = w; }
            LDS_WAIT();
#pragma unroll
            for (int i2 = 0; i2 < 2; ++i2) { const int row = i2 * 16 + (lane >> 2), chn = lane & 3; const u32x4 o = *(const LAS u32x4*)(otb + row * 80 + chn * 16); const u32x4 z = zz[i2];
                u32x4 w; w.x = cvtpk(bflo(o.x) * silu(bflo(z.x)), bfhi(o.x) * silu(bfhi(z.x))); w.y = cvtpk(bflo(o.y) * silu(bflo(z.y)), bfhi(o.y) * silu(bfhi(z.y)));
                         w.z = cvtpk(bflo(o.z) * silu(bflo(z.z)), bfhi(o.z) * silu(bfhi(z.z))); w.w = cvtpk(bflo(o.w) * silu(bflo(z.w)), bfhi(o.w) * silu(bfhi(z.w)));
                *(u32x4*)(ybase + (size_t)row * ldq + 32 * d + chn * 8) = w; }
        }
        LDS_WAIT();
    }
}

__device__ __forceinline__ void conv_task(bf16_t* h, const float* cw, int b, int c, int part, int lane) {
    const int th = part >> 1, ch = (part & 1) * 512 + lane * 8, t0 = c * 64 + th * 32;
    float w0[8], w1[8], w2[8], um2[8], um1[8];
#pragma unroll
    for (int e = 0; e < 8; ++e) { w0[e] = cw[ch + e]; w1[e] = cw[D + ch + e]; w2[e] = cw[2 * D + ch + e]; um2[e] = 0.f; um1[e] = 0.f; }
    bf16_t* row0 = h + (size_t)(b * SEQ + t0) * HP;
    if (t0 >= 2) {
        const u32x4 a2 = *(const u32x4*)(row0 - 2 * (size_t)HP + KOFF + ch), b2 = *(const u32x4*)(row0 - 2 * (size_t)HP + VOFF + ch);
        const u32x4 a1 = *(const u32x4*)(row0 - (size_t)HP + KOFF + ch), b1 = *(const u32x4*)(row0 - (size_t)HP + VOFF + ch);
#pragma unroll
        for (int e = 0; e < 4; ++e) { um2[2 * e] = bflo(a2[e]) * bflo(b2[e]); um2[2 * e + 1] = bfhi(a2[e]) * bfhi(b2[e]); um1[2 * e] = bflo(a1[e]) * bflo(b1[e]); um1[2 * e + 1] = bfhi(a1[e]) * bfhi(b1[e]); }
    }
    u32x4 na[4], nb[4], np[4], nz[4];
#pragma unroll
    for (int r = 0; r < 4; ++r) { bf16_t* row = row0 + (size_t)r * HP; na[r] = *(const u32x4*)(row + KOFF + ch); nb[r] = *(const u32x4*)(row + VOFF + ch); np[r] = *(const u32x4*)(row + QOFF + ch); nz[r] = *(const u32x4*)(row + ZOFF + ch); }
    for (int tb = 0; tb < 32; tb += 4) {
        u32x4 pa[4], pb[4], pp[4], pz[4];
#pragma unroll
        for (int r = 0; r < 4; ++r) { pa[r] = na[r]; pb[r] = nb[r]; pp[r] = np[r]; pz[r] = nz[r]; }
        if (tb + 4 < 32) {
#pragma unroll
            for (int r = 0; r < 4; ++r) { bf16_t* row = row0 + (size_t)(tb + 4 + r) * HP; na[r] = *(const u32x4*)(row + KOFF + ch); nb[r] = *(const u32x4*)(row + VOFF + ch); np[r] = *(const u32x4*)(row + QOFF + ch); nz[r] = *(const u32x4*)(row + ZOFF + ch); } }
#pragma unroll
        for (int r = 0; r < 4; ++r) { float u[8]; u32x4 o;
#pragma unroll
            for (int e = 0; e < 4; ++e) { u[2 * e] = bflo(pa[r][e]) * bflo(pb[r][e]); u[2 * e + 1] = bfhi(pa[r][e]) * bfhi(pb[r][e]); }
#pragma unroll
            for (int e = 0; e < 4; ++e) { const float c0 = w0[2 * e] * um2[2 * e] + w1[2 * e] * um1[2 * e] + w2[2 * e] * u[2 * e], c1 = w0[2 * e + 1] * um2[2 * e + 1] + w1[2 * e + 1] * um1[2 * e + 1] + w2[2 * e + 1] * u[2 * e + 1];
                o[e] = pk2(bflo(pp[r][e]) * c0 * silu(bflo(pz[r][e])), bfhi(pp[r][e]) * c1 * silu(bfhi(pz[r][e]))); }
            *(u32x4*)(row0 + (size_t)(tb + r) * HP + QOFF + ch) = o;
#pragma unroll
            for (int e = 0; e < 8; ++e) { um2[e] = um1[e]; um1[e] = u[e]; } }
    }
}

__device__ __forceinline__ void mixer_phase(const Args& a, unsigned char* ws, int layer, LAS unsigned char* lds, int gw, int NGW, int wave, int lane) {
    LAS unsigned char* kbuf = lds + wave * WAVE_LDS; LAS unsigned char* vbuf = kbuf + 9216; LAS float* tab = (LAS float*)(kbuf + 18432);
    bf16_t* h = (bf16_t*)(ws + WS_H); const bf16_t* kvm = (const bf16_t*)(ws + WS_KVMEM);
    const bool is_attn = (layer & 1) == 0;
    const int LW = NGW / 8, x = gw / LW;
    const int b = x >> 1, cbeg = (x & 1) * 64;
    unsigned* ctr = (unsigned*)(ws + WS_QCTR) + (layer * 8 + x) * 64;
    const int n_mix = is_attn ? 1024 : 256, ntask = n_mix;
    {
        const int wgx = (gw % LW) >> 3, mh = wgx & 3, grp = wgx >> 2, tid = wave * 64 + lane;
        LAS unsigned char* Kl = lds; LAS unsigned char* Vl = lds + 256 * 272;
        const bf16_t* kb = kvm + (size_t)b * 256 * 4096 + layer * 1024 + mh * 128;
        for (int kv = 0; kv < 2; ++kv) { u32x4 tk[8];
#pragma unroll
            for (int i = 0; i < 8; ++i) { const int id = tid + 512 * i, row = id >> 4, chn = id & 15; tk[i] = *(const u32x4*)(kb + kv * 512 + (size_t)row * 4096 + chn * 8); }
#pragma unroll
            for (int i = 0; i < 8; ++i) { const int id = tid + 512 * i, row = id >> 4, chn = id & 15; *(LAS u32x4*)((kv ? Vl : Kl) + row * 272 + chn * 16) = tk[i]; } }
        __syncthreads();
        for (int i = 0; i < 2; ++i) { int lane; asm volatile("v_mbcnt_lo_u32_b32 %0, -1, 0\n\tv_mbcnt_hi_u32_b32 %0, -1, %0" : "=v"(lane)); const int qbi = grp * 16 + wave * 2 + i, c = cbeg + (qbi >> 1), qh = qbi & 1; const size_t R0 = (size_t)b * SEQ + c * 64 + qh * 32;
            bf16_t* qb = h + R0 * HP + QMOFF + mh * 128;
            attn_task<128, 32, 1, false, false>(qb, nullptr, nullptr, h + R0 * HP + ZOFF + 1024 + mh * 128, qb, HP, 4096, 8, 0, 0, 0.08838834764831845f * LOG2E, Kl, Vl, (const LAS float*)(lds + 139264 + wave * 2560), lane); }
        __syncthreads();
    }
    for (;;) {
        int lane; asm volatile("v_mbcnt_lo_u32_b32 %0, -1, 0\n\tv_mbcnt_hi_u32_b32 %0, -1, %0" : "=v"(lane));
        unsigned tq = 0; if (lane == 0) tq = __hip_atomic_fetch_add(ctr, 1u, __ATOMIC_RELAXED, __HIP_MEMORY_SCOPE_AGENT);
        const int t = __builtin_amdgcn_readfirstlane((int)tq);
        if (t >= ntask) break;
        if (is_attn) {
            const int head = t & 15, c = cbeg + 63 - (t >> 4), jlo = c < 8 ? 0 : c - 8; const size_t R0 = (size_t)b * SEQ + c * 64;
            const float* rb = a.rel + ((size_t)(layer >> 1) * 16 + head) * 257;
            LDS_WAIT();
#pragma unroll
            for (int k = 0; k < 4; ++k) { const int xx = lane + 64 * k, rel = 191 - xx; tab[xx] = rb[(rel > 128 ? 128 : rel) + 128] * LOG2E; }
            LDS_WAIT();
            bf16_t* qb = h + R0 * HP + QOFF + head * 64; const bf16_t* kb = h + ((size_t)b * SEQ + jlo * 64) * HP + KOFF + head * 64;
            attn_task<64, 32, 2, true>(qb, kb, kb + (VOFF - KOFF), h + R0 * HP + ZOFF + head * 64, qb, HP, HP, 2 * (c - jlo + 1), c >= 8 ? (18 - (2 * (c - 8)) % 18) % 18 : 0, 64 * (c - jlo), 0.125f * LOG2E, kbuf, vbuf, tab, lane);
        } else {
            conv_task(h, a.convw + (size_t)(layer >> 1) * 3 * D, b, cbeg + (t >> 2), t & 3, lane);
        }
    }
}

#define XB_TMO      128
#define XB_XCNT(j)  (256  + 64 * (j))
#define XB_XSUB(j)  (1280 + 64 * (j))
#define XB_XGEN(j)  (2304 + 64 * (j))
#define XB_TOP      3328
#define XB_TOPGEN   3392
#define XCD_BAR_WORDS 3456
#define XB_SPIN_CAP (1u << 18)

__device__ __forceinline__ unsigned xb_ld(unsigned* p)              { return __hip_atomic_load(p, __ATOMIC_RELAXED, __HIP_MEMORY_SCOPE_AGENT); }
__device__ __forceinline__ unsigned xb_add(unsigned* p, unsigned v) { return __hip_atomic_fetch_add(p, v, __ATOMIC_RELAXED, __HIP_MEMORY_SCOPE_AGENT); }
__device__ __forceinline__ unsigned xb_xcc_id() { return (unsigned)__builtin_amdgcn_s_getreg((3 << 11) | 20) & 0xFu; }
#define XB_SPIN(cond, bar) do { unsigned _sp = 0; while (cond) { __builtin_amdgcn_s_sleep(1); \
    if ((++_sp & 255u) == 0u) { if (xb_ld(&(bar)[XB_TMO])) break; if (_sp > XB_SPIN_CAP) { atomicAdd(&(bar)[XB_TMO], 1u); break; } } } } while (0)

struct XcdBarrier {
    unsigned* bar; unsigned x; unsigned wv;
    volatile LAS unsigned* st;
};

__device__ __forceinline__ XcdBarrier xcd_barrier_post(unsigned* bar, volatile LAS unsigned* st) {
    XcdBarrier b; b.bar = bar; b.x = xb_xcc_id(); b.st = st;
    if (threadIdx.x == 0) (void)xb_add(&bar[XB_XCNT(b.x)], 1u);
    return b;
}
__device__ __forceinline__ void xcd_barrier_complete(unsigned* bar, unsigned x, unsigned& nloc, unsigned& nx) {
    const unsigned G = gridDim.x * gridDim.y * gridDim.z;
    unsigned sum, cnt, mine, sp = 0u;
    for (;;) {
        sum = 0u; cnt = 0u; mine = 0u;
#pragma unroll
        for (unsigned j = 0; j < 16; ++j) { const unsigned c = xb_ld(&bar[XB_XCNT(j)]); sum += c; cnt += (c > 0u) ? 1u : 0u; mine = (j == x) ? c : mine; }
        if (sum == G) break;
        __builtin_amdgcn_s_sleep(1);
        if ((++sp & 255u) == 0u) { if (xb_ld(&bar[XB_TMO])) break; if (sp > XB_SPIN_CAP) { atomicAdd(&bar[XB_TMO], 1u); break; } }
    }
    nloc = mine > 0u ? mine : 1u; nx = cnt > 0u ? cnt : 1u;
}

__device__ __forceinline__ void xcd_barrier(const XcdBarrier& b) {
    asm volatile("s_waitcnt vmcnt(0)" ::: "memory");
    __syncthreads();
    if (b.wv == 0 && lane_now() == 0) {
        unsigned* bar = b.bar;
        __builtin_amdgcn_s_waitcnt(0);
        unsigned nloc = b.st[0], nx = b.st[1];
        if (nloc == 0u) { xcd_barrier_complete(bar, b.x, nloc, nx); b.st[0] = nloc; b.st[1] = nx; }
        const unsigned old = xb_add(&bar[XB_XSUB(b.x)], 1u);
        const unsigned gen = old / nloc;
        if (old + 1u == (gen + 1u) * nloc) {
            __builtin_amdgcn_fence(__ATOMIC_RELEASE, "agent");
            asm volatile("s_waitcnt vmcnt(0)" ::: "memory");
            const unsigned og = xb_add(&bar[XB_TOP], 1u);
            const unsigned tg = og / nx;
            if (og + 1u == (tg + 1u) * nx) xb_add(&bar[XB_TOPGEN], 1u);
            else XB_SPIN(xb_ld(&bar[XB_TOPGEN]) == tg, bar);
            __builtin_amdgcn_fence(__ATOMIC_ACQUIRE, "agent");
            xb_add(&bar[XB_XGEN(b.x)], 1u);
            asm volatile("s_waitcnt vmcnt(0)" ::: "memory");
        } else {
            XB_SPIN(xb_ld(&bar[XB_XGEN(b.x)]) == gen, bar);
            __builtin_amdgcn_fence(__ATOMIC_ACQUIRE, "agent");
            asm volatile("s_waitcnt vmcnt(0)" ::: "memory");
        }
    }
    __syncthreads();
}

__global__ void __launch_bounds__(NWAVES * 64, 2) fwd_kernel(Args a) {
    extern __shared__ __attribute__((aligned(16))) unsigned char lds_raw[];
    LAS unsigned char* lds = (LAS unsigned char*)lds_raw;
    if (threadIdx.x < 64) ((LAS unsigned*)(lds + LDS_BAR))[threadIdx.x] = 0u;
    __syncthreads();
    XcdBarrier bar = xcd_barrier_post((unsigned*)(a.ws + WS_BAR), (volatile LAS unsigned*)(lds + LDS_BAR));
    const int wave_sg = __builtin_amdgcn_readfirstlane((int)(threadIdx.x >> 6)); bar.wv = (unsigned)wave_sg;
    for (int ph0 = a.ph_lo; ph0 < a.ph_hi; ++ph0) {
        int ph = ph0; asm volatile("" : "+s"(ph));
        size_t wzero = 0; asm volatile("" : "+s"(wzero)); unsigned char* ws = a.ws + wzero;
        const int wave = wave_sg;
#define lane lane_now()
#define tid (wave_sg * 64 + lane_now())
        const int G = gridDim.x, bx = blockIdx.x, vcu = (G % 8 == 0) ? (bx % 8) * (G / 8) + bx / 8 : bx;
        const int gw = vcu * NWAVES + wave, NGW = G * NWAVES;
        bf16_t* h = (bf16_t*)(ws + WS_H); bf16_t* xb = (bf16_t*)(ws + WS_XB);
        float* stats = (float*)(ws + WS_STATS);
        if (ph == 0) prologue(a, ws, lds, gw, NGW, wave, lane);
        else if (ph == 13) {
            const float* st = stats + (size_t)4 * M * 2; const float* g = a.lng + 3 * D; const float* bb = a.lnb + 3 * D;
            f32x4 gg[4], b4[4];
#pragma unroll
            for (int j = 0; j < 4; ++j) { gg[j] = ((const f32x4*)g)[64 * j + lane]; b4[j] = ((const f32x4*)bb)[64 * j + lane]; }
            for (int m = gw; m < M; m += 4 * NGW) {
                f32x4 v[4][4]; f32x2 sr[4];
#pragma unroll
                for (int r = 0; r < 4; ++r) { sr[r] = *(const f32x2*)(st + 2 * (size_t)(m + r * NGW));
#pragma unroll
                    for (int j = 0; j < 4; ++j) v[r][j] = ((const f32x4*)(a.out + (size_t)(m + r * NGW) * D))[64 * j + lane]; }
#pragma unroll
                for (int r = 0; r < 4; ++r) { const float mu = sr[r].x * INV_D, var = sr[r].y * INV_D - mu * mu, rstd = rsqrtf(var + LN_EPS);
                    f32x4* xr = (f32x4*)(a.out + (size_t)(m + r * NGW) * D) + lane;
#pragma unroll
                    for (int j = 0; j < 4; ++j) xr[64 * j] = (v[r][j] - mu) * rstd * gg[j] + b4[j]; }
            }
        } else if (ph == 1 || (ph - 2) % 3 == 2) {
            const int l = ph == 1 ? 0 : (ph - 2) / 3 + 1;
            if (ph == 1) { pg8::Gemm g{(const bf16_t*)(ws + WS_MEMB), (const bf16_t*)(ws + WS_WKV), BATCH * 256, 4096, D, D}; pg8::StaticOrder S; S.init(BATCH * 256, 4096, G, bx);
                pg8::EpiPlain E{(bf16_t*)(ws + WS_KVMEM), 4096};
                pg8::gemm_phase<pg8::EpiPlain, pg8::StaticOrder, true, true>(lds, g, S, E, tid); }
            pg8::Gemm g{xb, (const bf16_t*)(ws + WS_WIN) + (size_t)l * HP * D, M, HP, D, D}; pg8::StaticOrder S; S.init(M, HP, G, bx);
            pg8::EpiIn E{h, HP, stats + (size_t)l * M * 2, (const float*)(ws + WS_CS) + l * HP, (const float*)(ws + WS_BW) + l * HP};
            pg8::gemm_phase<pg8::EpiIn, pg8::StaticOrder, true, true>(lds, g, S, E, wave_sg * 64 + lane_now());
        } else if ((ph - 2) % 3 == 0) {
            mixer_phase(a, ws, (ph - 2) / 3, lds, gw, NGW, wave, lane);
        } else {
            const int l = (ph - 2) / 3;
            pg8::Gemm g{h, (const bf16_t*)(ws + WS_WOUT) + (size_t)l * D * EB, M, D, EB, HP}; pg8::StaticOrder S; S.init(M, D, G, bx);
            pg8::EpiOut E{l == 0 ? a.x : (l == 3 ? a.out : nullptr), l >= 2 ? a.out : nullptr, xb, stats + (size_t)l * M * 2, stats + (size_t)(l + 1) * M * 2, l ? a.lng + (l - 1) * D : nullptr, l ? a.lnb + (l - 1) * D : nullptr, l < 3 ? 1 : 0};
            pg8::gemm_phase<pg8::EpiOut, pg8::StaticOrder, true, true>(lds, g, S, E, wave_sg * 64 + lane_now());
        }
        if (ph + 1 < a.ph_hi) { if (a.ph_hi > 1000) cg::this_grid().sync();
            { XcdBarrier bb = bar; size_t bz = 0; asm volatile("" : "+s"(bz)); bb.bar = bar.bar + bz; xcd_barrier(bb); } }
    }
#undef lane
#undef tid
}

extern "C" void kernel_launch(void* const* d_in, const int* in_sizes, int n_in, void* d_out, int out_size, void* d_ws, size_t ws_size, hipStream_t stream) {
    static int grid = 0;
    if (grid == 0) {
        if (n_in != 9 || out_size != M * D || ws_size < WS_END) { fprintf(stderr, "kernel_launch: unexpected shapes (n_in %d out %d ws %zu)\n", n_in, out_size, ws_size); grid = -1; return; }
        int dev = 0, cus = 0, per_cu = 0;
        hipGetDevice(&dev); hipDeviceGetAttribute(&cus, hipDeviceAttributeMultiprocessorCount, dev);
        if (hipFuncSetAttribute((const void*)fwd_kernel, hipFuncAttributeMaxDynamicSharedMemorySize, LDS_BYTES) != hipSuccess) { fprintf(stderr, "kernel_launch: hipFuncSetAttribute failed\n"); grid = -1; return; }
        if (hipOccupancyMaxActiveBlocksPerMultiprocessor(&per_cu, (const void*)fwd_kernel, NWAVES * 64, LDS_BYTES) != hipSuccess || per_cu < 1) { fprintf(stderr, "kernel_launch: occupancy query says %d\n", per_cu); per_cu = 1; }
        (void)hipGetLastError();
        grid = cus;
    }
    if (grid < 0) return;
    hipMemsetAsync((char*)d_ws, 0, CTL_BYTES, stream);
    Args a{};
    a.x = (const float*)d_in[0]; a.mem = (const float*)d_in[1]; a.w_in = (const float*)d_in[2]; a.w_kv = (const float*)d_in[3]; a.w_out = (const float*)d_in[4];
    a.rel = (const float*)d_in[5]; a.convw = (const float*)d_in[6]; a.lng = (const float*)d_in[7]; a.lnb = (const float*)d_in[8];
    a.out = (float*)d_out; a.ws = (unsigned char*)d_ws;
#if MK_MULTI
    for (int ph = 0; ph < 14; ++ph) { a.ph_lo = ph; a.ph_hi = ph + 1; hipLaunchKernelGGL(fwd_kernel, dim3(grid), dim3(NWAVES * 64), LDS_BYTES, stream, a); }
#else
    a.ph_lo = 0; a.ph_hi = 14;
    void* args[] = {&a};
    hipError_t e = hipLaunchCooperativeKernel((const void*)fwd_kernel, dim3(grid), dim3(NWAVES * 64), args, LDS_BYTES, stream);
    if (e != hipSuccess) fprintf(stderr, "cooperative launch failed: %s (grid %d)\n", hipGetErrorString(e), grid);
#endif
}
```

```cpp
#include <hip/hip_runtime.h>
#include <hip/hip_cooperative_groups.h>
#include <cstdio>
#include <cstdint>
namespace cg = cooperative_groups;
#ifndef MK_MULTI
#define MK_MULTI 0
#endif
namespace pg8 {
#define PG8_LAS __attribute__((address_space(3)))
typedef unsigned short bf16_t;
typedef short bf16x8 __attribute__((ext_vector_type(8)));
typedef float f32x4 __attribute__((ext_vector_type(4)));
typedef unsigned u32x4 __attribute__((ext_vector_type(4)));
constexpr int BM = 256, BK = 64, HALF = 128, HTB = HALF * BK * 2  , STAGE_BYTES = 8 * HTB, NXCD = 8, WGM = 4;

__host__ __device__ __forceinline__ int lds_byte(int r, int c) { const int st = (r >> 4) * 2 + (c >> 5), rr = r & 15, cc = c & 31, ob = rr * 64 + cc * 2; return st * 1024 + (ob ^ (((ob >> 9) & 1) << 5)); }
__host__ __device__ __forceinline__ void stage_rc(int b, int& R, int& C) { const int st = b / 1024, sb = b % 1024, swz = sb ^ (((sb >> 9) & 1) << 5); R = (st >> 1) * 16 + swz / 64; C = (st & 1) * 32 + (swz % 64) / 2; }
__host__ __device__ __forceinline__ int perm32(int rho) { const int n = rho >> 4, i = rho & 15; return 8 * (i >> 2) + 4 * n + (i & 3); }

struct Unit { int pm, pn; };

struct StaticOrder {
    int nM, nN, nwg, G, c;
    __host__ __device__ void init(int M, int N, int G_, int c_) { nM = M / BM; nN = N / BM; nwg = nM * nN; G = G_; c = c_; }
    __host__ __device__ bool next(int i, Unit& u) const {
        const long L = (long)i * G + c; if (L >= nwg) return false;
        int wgid = (int)L; { const int q = nwg / NXCD, r = nwg % NXCD, xcd = wgid % NXCD, off = wgid / NXCD; wgid = (xcd < r ? xcd * (q + 1) : r * (q + 1) + (xcd - r) * q) + off; }
        const int nig = WGM * nN, gid = wgid / nig, fm = gid * WGM, gsz = (nM - fm) < WGM ? (nM - fm) : WGM;
        u.pm = fm + ((wgid % nig) % gsz); u.pn = (wgid % nig) / gsz; return true;
    }
    __device__ __forceinline__ void a_ready(const Unit&) const {}
    __device__ __forceinline__ void done(const Unit&) const {}
};

struct Gemm { const bf16_t* A; const bf16_t* Bt; int M, N, K, lda; };
__device__ __forceinline__ unsigned cvt_pk_bf16(float lo, float hi) { unsigned r; asm volatile("v_cvt_pk_bf16_f32 %0, %1, %2" : "=v"(r) : "v"(lo), "v"(hi)); return r; }
typedef float f32x2 __attribute__((ext_vector_type(2)));
constexpr float LN_EPS = 1e-5f, INV_D = 1.0f / 1024.0f, DN_ALPHA = 1.681792830507429f;

struct EpiPlain {
    static constexpr bool PERM = true, AFTER_DRAIN = false;
    bf16_t* O; int ldc;
    __device__ __forceinline__ void operator()(const f32x4 (&acc)[2][2][4][2], const Unit& u, int wr, int wc, int fr, int fq) const {
        const int row0 = u.pm * BM + wr * 64 + fr, col0 = u.pn * BM + wc * 32 + 8 * fq;
#pragma unroll
        for (int ai = 0; ai < 2; ++ai)
#pragma unroll
            for (int m = 0; m < 4; ++m) { bf16_t* rowp = O + (size_t)(row0 + ai * HALF + m * 16) * ldc + col0;
#pragma unroll
                for (int bj = 0; bj < 2; ++bj) { const f32x4 v0 = acc[ai][bj][m][0], v1 = acc[ai][bj][m][1];
                    u32x4 w; w.x = cvt_pk_bf16(v0[0], v0[1]); w.y = cvt_pk_bf16(v0[2], v0[3]); w.z = cvt_pk_bf16(v1[0], v1[1]); w.w = cvt_pk_bf16(v1[2], v1[3]);
                    *(u32x4*)(rowp + bj * HALF) = w; } }
    }
};
struct EpiIn {
    static constexpr bool PERM = true, AFTER_DRAIN = false;
    bf16_t* O; int ldc; const float* stats; const float* cs; const float* bw;
    __device__ __forceinline__ void operator()(const f32x4 (&acc)[2][2][4][2], const Unit& u, int wr, int wc, int fr, int fq) const {
        const int row0 = u.pm * BM + wr * 64 + fr, col0 = u.pn * BM + wc * 32 + 8 * fq;
        f32x2 st[2][4];
#pragma unroll
        for (int ai = 0; ai < 2; ++ai)
#pragma unroll
            for (int m = 0; m < 4; ++m) st[ai][m] = *(const f32x2*)(stats + 2 * (size_t)(row0 + ai * HALF + m * 16));
        f32x4 c4[2][2], b4[2][2];
#pragma unroll
        for (int bj = 0; bj < 2; ++bj)
#pragma unroll
            for (int n = 0; n < 2; ++n) { c4[bj][n] = *(const f32x4*)(cs + col0 + bj * HALF + 4 * n); b4[bj][n] = *(const f32x4*)(bw + col0 + bj * HALF + 4 * n); }
#pragma unroll
        for (int ai = 0; ai < 2; ++ai)
#pragma unroll
            for (int m = 0; m < 4; ++m) { const int r = row0 + ai * HALF + m * 16;
                const float mu = st[ai][m].x * INV_D, var = st[ai][m].y * INV_D - mu * mu, rstd = rsqrtf(var + LN_EPS);
                bf16_t* rowp = O + (size_t)r * ldc + col0;
#pragma unroll
                for (int bj = 0; bj < 2; ++bj) { const f32x4 v0 = (acc[ai][bj][m][0] - c4[bj][0] * mu) * rstd + b4[bj][0], v1 = (acc[ai][bj][m][1] - c4[bj][1] * mu) * rstd + b4[bj][1];
                    u32x4 w; w.x = cvt_pk_bf16(v0[0], v0[1]); w.y = cvt_pk_bf16(v0[2], v0[3]); w.z = cvt_pk_bf16(v1[0], v1[1]); w.w = cvt_pk_bf16(v1[2], v1[3]);
                    *(u32x4*)(rowp + bj * HALF) = w; } }
    }
};
struct EpiOut {
    static constexpr bool PERM = true, AFTER_DRAIN = false;
    const float* srcf; float* dstf; bf16_t* xb; const float* st_old; float* st_new; const float* g; const float* b; int wbf;
    template <bool SRCF>
    __device__ __forceinline__ void body(const f32x4 (&acc)[2][2][4][2], const Unit& u, int wr, int wc, int fr, int fq) const {
        const int row0 = u.pm * BM + wr * 64 + fr, col0 = u.pn * BM + wc * 32 + 8 * fq;
        f32x2 st[2]; st[0] = *(const f32x2*)(st_old + 2 * (size_t)row0);
        f32x4 g4[2][2], b4[2][2];
#pragma unroll
        for (int bj = 0; bj < 2; ++bj)
#pragma unroll
            for (int n = 0; n < 2; ++n) { g4[bj][n] = g ? *(const f32x4*)(g + col0 + bj * HALF + 4 * n) : (f32x4){1.f, 1.f, 1.f, 1.f}; b4[bj][n] = b ? *(const f32x4*)(b + col0 + bj * HALF + 4 * n) : (f32x4){0.f, 0.f, 0.f, 0.f}; }
        f32x4 po[SRCF ? 1 : 2][2][SRCF ? 2 : 1];
#pragma unroll
        for (int bj = 0; bj < 2; ++bj) { if (!SRCF) po[0][bj][0] = *(const f32x4*)(xb + (size_t)row0 * 1024 + col0 + bj * HALF); }
#pragma unroll
        for (int i = 0; i < 8; ++i) { const int ai = i >> 2, m = i & 3; const int r = row0 + ai * HALF + m * 16;
            if (i < 7) { const int rn = row0 + ((i + 1) >> 2) * HALF + ((i + 1) & 3) * 16; st[(i + 1) & 1] = *(const f32x2*)(st_old + 2 * (size_t)rn);
#pragma unroll
                for (int bj = 0; bj < 2; ++bj) { if (!SRCF) po[SRCF ? 0 : ((i + 1) & 1)][bj][0] = *(const f32x4*)(xb + (size_t)rn * 1024 + col0 + bj * HALF); } }
            if (SRCF) {
#pragma unroll
                for (int bj = 0; bj < 2; ++bj) { po[0][bj][0] = *(const f32x4*)(srcf + (size_t)r * 1024 + col0 + bj * HALF); po[0][bj][SRCF ? 1 : 0] = *(const f32x4*)(srcf + (size_t)r * 1024 + col0 + bj * HALF + 4); } }
            asm volatile("" ::: "memory");
            const float mu = st[i & 1].x * INV_D, var = st[i & 1].y * INV_D - mu * mu, rstd = rsqrtf(var + LN_EPS);
            const size_t off = (size_t)r * 1024 + col0; float s = 0.f, q = 0.f;
#pragma unroll
            for (int bj = 0; bj < 2; ++bj) { f32x4 v[2];
#pragma unroll
                for (int n = 0; n < 2; ++n) { f32x4 pv;
                    if (SRCF) pv = po[0][bj][SRCF ? n : 0];
                    else { const u32x4 raw = __builtin_bit_cast(u32x4, po[SRCF ? 0 : (i & 1)][bj][0]); const unsigned w0 = raw[2 * n], w1 = raw[2 * n + 1];
                           pv = (f32x4){__builtin_bit_cast(float, w0 << 16), __builtin_bit_cast(float, w0 & 0xffff0000u), __builtin_bit_cast(float, w1 << 16), __builtin_bit_cast(float, w1 & 0xffff0000u)}; }
                    const f32x4 x = (pv - mu) * rstd * g4[bj][n] + b4[bj][n]; v[n] = x * DN_ALPHA + acc[ai][bj][m][n];
                    s += (v[n][0] + v[n][1]) + (v[n][2] + v[n][3]); q += (v[n][0] * v[n][0] + v[n][1] * v[n][1]) + (v[n][2] * v[n][2] + v[n][3] * v[n][3]); }
                if (dstf) { *(f32x4*)(dstf + off + bj * HALF) = v[0]; *(f32x4*)(dstf + off + bj * HALF + 4) = v[1]; }
                if (wbf) { u32x4 w; w.x = cvt_pk_bf16(v[0][0], v[0][1]); w.y = cvt_pk_bf16(v[0][2], v[0][3]); w.z = cvt_pk_bf16(v[1][0], v[1][1]); w.w = cvt_pk_bf16(v[1][2], v[1][3]);
                       *(u32x4*)(xb + off + bj * HALF) = w; } }
            s += __shfl_xor(s, 16); s += __shfl_xor(s, 32); q += __shfl_xor(q, 16); q += __shfl_xor(q, 32);
            if (fq == 0) { unsafeAtomicAdd(st_new + 2 * (size_t)r, s); unsafeAtomicAdd(st_new + 2 * (size_t)r + 1, q); }
            asm volatile("" ::: "memory"); }
    }
    __device__ __forceinline__ void operator()(const f32x4 (&acc)[2][2][4][2], const Unit& u, int wr, int wc, int fr, int fq) const {
        if (srcf) body<true>(acc, u, wr, wc, fr, fq); else body<false>(acc, u, wr, wc, fr, fq);
    }
};
template <class Epi, class Sched, bool ALIGN_EPI = false, bool SP2 = false>
__device__ __forceinline__ void gemm_phase(PG8_LAS unsigned char* lds, const Gemm g, const Sched& S, const Epi& E, const int tid) {
    const int wid = __builtin_amdgcn_readfirstlane(tid >> 6), lane = tid & 63, wr = wid >> 2, wc = wid & 3, fr = lane & 15, fq = lane >> 4;
    const int K = g.K, nt = K / BK;
    unsigned voffA[2], voffB[2];
#pragma unroll
    for (int i = 0; i < 2; ++i) { int R, C; stage_rc(tid * 16 + i * 8192, R, C); const int Rb = Epi::PERM ? ((R & ~31) + perm32(R & 31)) : R;
        voffA[i] = (unsigned)(R * g.lda + C) * 2u; voffB[i] = (unsigned)(Rb * K + C) * 2u; }
    const size_t kstep = (size_t)(BK * 2);
    const size_t hstep = (size_t)HALF * K * 2;
    const size_t tstep = 2 * hstep; const size_t hstepA = (size_t)HALF * g.lda * 2; const size_t tstepA = 2 * hstepA;
    const unsigned ldsw = (unsigned)wid * 1024u;
    const int aoff = lds_byte(wr * 64 + fr, fq * 8), boff = lds_byte(wc * 32 + fr, fq * 8);
#define PG8_SA(b, h) (((b) * 2 + (h)) * HTB)
#define PG8_SB(b, h) ((4 + (b) * 2 + (h)) * HTB)
#define PG8_STAGE(bufoff, gbase, voff) do { _Pragma("unroll") for (int _i = 0; _i < 2; ++_i) \
        __builtin_amdgcn_global_load_lds((const unsigned*)((const char*)(gbase) + (voff)[_i]), (PG8_LAS unsigned*)(lds + (bufoff) + ldsw + _i * 8192), 16, 0, 0); } while (0)
#define PG8_LDA(dst, b, h) do { _Pragma("unroll") for (int m = 0; m < 4; ++m) _Pragma("unroll") for (int k = 0; k < 2; ++k) dst[m][k] = *(const PG8_LAS bf16x8*)(lds + PG8_SA(b, h) + aoff + m * 2048 + k * 1024); } while (0)
#define PG8_LDB(dst, b, h) do { _Pragma("unroll") for (int n = 0; n < 2; ++n) _Pragma("unroll") for (int k = 0; k < 2; ++k) dst[n][k] = *(const PG8_LAS bf16x8*)(lds + PG8_SB(b, h) + boff + n * 2048 + k * 1024); } while (0)
#define PG8_MMA(ai, bj, At, Bt) do { __builtin_amdgcn_s_setprio(1); _Pragma("unroll") for (int m = 0; m < 4; ++m) _Pragma("unroll") for (int n = 0; n < 2; ++n) _Pragma("unroll") for (int k = 0; k < 2; ++k) \
        acc[ai][bj][m][n] = __builtin_amdgcn_mfma_f32_16x16x32_bf16(Bt[n][k], At[m][k], acc[ai][bj][m][n], 0, 0, 0); __builtin_amdgcn_s_setprio(0); } while (0)
#define PG8_WAIT_V(n) asm volatile("s_waitcnt vmcnt(" #n ")" ::: "memory")
#define PG8_WAIT_L(n) asm volatile("s_waitcnt lgkmcnt(" #n ")" ::: "memory")
#define PG8_BAR __builtin_amdgcn_s_barrier()
#define PG8_SCHED __builtin_amdgcn_sched_barrier(0)
    Unit cur, nxt; int ui = 0;
    if (!S.next(0, cur)) return;
    f32x4 acc[2][2][4][2];
#pragma unroll
    for (int a = 0; a < 2; ++a)
#pragma unroll
        for (int b = 0; b < 2; ++b)
#pragma unroll
            for (int m = 0; m < 4; ++m)
#pragma unroll
                for (int n = 0; n < 2; ++n) acc[a][b][m][n] = (f32x4){0.f, 0.f, 0.f, 0.f};
    bf16x8 At[4][2], B0[2][2], B1[2][2];
    const char* cA = (const char*)g.A + (size_t)cur.pm * tstepA; const char* cB = (const char*)g.Bt + (size_t)cur.pn * tstep;
    S.a_ready(cur);
    if constexpr (SP2) {
        PG8_STAGE(PG8_SB(0, 0), cB, voffB); PG8_STAGE(PG8_SB(0, 1), cB + hstep, voffB); PG8_STAGE(PG8_SA(0, 0), cA, voffA); PG8_STAGE(PG8_SA(0, 1), cA + hstepA, voffA);
        if (wr == 1) PG8_BAR;
        PG8_WAIT_V(2); PG8_BAR;
        PG8_STAGE(PG8_SB(1, 0), cB + kstep, voffB); PG8_STAGE(PG8_SA(1, 0), cA + kstep, voffA); PG8_STAGE(PG8_SB(1, 1), cB + hstep + kstep, voffB);
        PG8_WAIT_V(6); PG8_BAR;
    } else {
        PG8_STAGE(PG8_SB(0, 0), cB, voffB); PG8_STAGE(PG8_SA(0, 0), cA, voffA); PG8_STAGE(PG8_SB(0, 1), cB + hstep, voffB); PG8_STAGE(PG8_SA(0, 1), cA + hstepA, voffA);
        if (wr == 1) PG8_BAR;
        PG8_WAIT_V(4); PG8_BAR;
        PG8_STAGE(PG8_SB(1, 0), cB + kstep, voffB); PG8_STAGE(PG8_SA(1, 0), cA + kstep, voffA); PG8_STAGE(PG8_SB(1, 1), cB + hstep + kstep, voffB);
        PG8_WAIT_V(6); PG8_BAR;
    }
    for (;;) {
        const bool has_next = S.next(ui + 1, nxt);
        const char* nA = has_next ? (const char*)g.A + (size_t)nxt.pm * tstepA : cA; const char* nB = has_next ? (const char*)g.Bt + (size_t)nxt.pn * tstep : cB;
        for (int t = 0; t < nt; t += 2) {
            const bool last = (t == nt - 2);
            const char* a1 = cA + (size_t)(t + 1) * kstep;
            const char* a2 = last ? nA : cA + (size_t)(t + 2) * kstep; const char* b2 = last ? nB : cB + (size_t)(t + 2) * kstep;
            const char* a3 = a2 + kstep; const char* b3 = b2 + kstep;
            if (last && has_next) S.a_ready(nxt);
            if constexpr (SP2) {
            PG8_LDB(B0, 0, 0); PG8_LDB(B1, 0, 1); PG8_SCHED; PG8_LDA(At, 0, 0); PG8_STAGE(PG8_SA(1, 1), a1 + hstepA, voffA);
            PG8_WAIT_V(8); PG8_WAIT_L(0); PG8_BAR; PG8_MMA(0, 0, At, B0); PG8_MMA(0, 1, At, B1); PG8_BAR; PG8_SCHED;
            PG8_LDA(At, 0, 1); PG8_STAGE(PG8_SB(0, 0), b2, voffB); PG8_STAGE(PG8_SB(0, 1), b2 + hstep, voffB); PG8_STAGE(PG8_SA(0, 0), a2, voffA);
            PG8_WAIT_V(8); PG8_WAIT_L(0); PG8_BAR; PG8_MMA(1, 0, At, B0); PG8_MMA(1, 1, At, B1); PG8_BAR; PG8_SCHED;
            PG8_LDB(B0, 1, 0); PG8_LDB(B1, 1, 1); PG8_SCHED; PG8_LDA(At, 1, 0); PG8_STAGE(PG8_SA(0, 1), a2 + hstepA, voffA);
            PG8_WAIT_V(8); PG8_WAIT_L(0); PG8_BAR; PG8_MMA(0, 0, At, B0); PG8_MMA(0, 1, At, B1); PG8_BAR; PG8_SCHED;
            PG8_LDA(At, 1, 1); PG8_STAGE(PG8_SB(1, 0), b3, voffB); PG8_STAGE(PG8_SB(1, 1), b3 + hstep, voffB); PG8_STAGE(PG8_SA(1, 0), a3, voffA);
            PG8_WAIT_V(8); PG8_WAIT_L(0); PG8_BAR; PG8_MMA(1, 0, At, B0); PG8_MMA(1, 1, At, B1); PG8_BAR; PG8_SCHED;
            } else {
            PG8_LDB(B0, 0, 0); PG8_SCHED; PG8_LDA(At, 0, 0); PG8_STAGE(PG8_SA(1, 1), a1 + hstepA, voffA);
            PG8_WAIT_L(8); PG8_BAR; PG8_WAIT_L(0); PG8_MMA(0, 0, At, B0); PG8_BAR; PG8_SCHED;
            PG8_LDB(B1, 0, 1); PG8_STAGE(PG8_SB(0, 0), b2, voffB);
            PG8_BAR; PG8_WAIT_L(0); PG8_MMA(0, 1, At, B1); PG8_BAR;
            PG8_LDA(At, 0, 1); PG8_STAGE(PG8_SA(0, 0), a2, voffA);
            PG8_BAR; PG8_WAIT_L(0); PG8_MMA(1, 0, At, B0); PG8_BAR; PG8_SCHED;
            PG8_STAGE(PG8_SB(0, 1), b2 + hstep, voffB);
            PG8_WAIT_V(6); PG8_BAR; PG8_MMA(1, 1, At, B1); PG8_BAR;
            PG8_LDB(B0, 1, 0); PG8_SCHED; PG8_LDA(At, 1, 0); PG8_STAGE(PG8_SA(0, 1), a2 + hstepA, voffA);
            PG8_WAIT_L(8); PG8_BAR; PG8_WAIT_L(0); PG8_MMA(0, 0, At, B0); PG8_BAR; PG8_SCHED;
            PG8_LDB(B1, 1, 1); PG8_STAGE(PG8_SB(1, 0), b3, voffB);
            PG8_BAR; PG8_WAIT_L(0); PG8_MMA(0, 1, At, B1); PG8_BAR;
            PG8_LDA(At, 1, 1); PG8_STAGE(PG8_SA(1, 0), a3, voffA);
            PG8_BAR; PG8_WAIT_L(0); PG8_MMA(1, 0, At, B0); PG8_BAR; PG8_SCHED;
            PG8_STAGE(PG8_SB(1, 1), b3 + hstep, voffB);
            PG8_WAIT_V(6); PG8_BAR; PG8_MMA(1, 1, At, B1); PG8_BAR;
            }
        }
        if constexpr (ALIGN_EPI) { if (wr == 0) PG8_BAR; }
        if constexpr (!Epi::AFTER_DRAIN) { E(acc, cur, wr, wc, fr, fq); S.done(cur); }
        if (!has_next) break;
#pragma unroll
        for (int a = 0; a < 2; ++a)
#pragma unroll
            for (int b = 0; b < 2; ++b)
#pragma unroll
                for (int m = 0; m < 4; ++m)
#pragma unroll
                    for (int n = 0; n < 2; ++n) acc[a][b][m][n] = (f32x4){0.f, 0.f, 0.f, 0.f};
        cur = nxt; cA = nA; cB = nB; ++ui;
        if constexpr (ALIGN_EPI) { if (wr == 1) PG8_BAR; }
    }
    PG8_WAIT_V(0);
    if constexpr (!ALIGN_EPI) { if (wr == 0) PG8_BAR; }
    PG8_BAR;
    if constexpr (Epi::AFTER_DRAIN) { E.fused(acc, cur, wr, wc, fr, fq, lds, wid, lane); S.done(cur); }
#undef PG8_SA
#undef PG8_SB
#undef PG8_STAGE
#undef PG8_LDA
#undef PG8_LDB
#undef PG8_MMA
#undef PG8_WAIT_V
#undef PG8_WAIT_L
#undef PG8_BAR
#undef PG8_SCHED
}
}
#define LAS __attribute__((address_space(3)))
typedef unsigned short bf16_t;
typedef short bf16x8 __attribute__((ext_vector_type(8)));
typedef float f32x4 __attribute__((ext_vector_type(4)));
typedef float f32x2 __attribute__((ext_vector_type(2)));
typedef float f32x16 __attribute__((ext_vector_type(16)));
typedef unsigned u32x4 __attribute__((ext_vector_type(4)));
typedef unsigned u32x2 __attribute__((ext_vector_type(2)));

constexpr int D = 1024, BATCH = 4, SEQ = 8192, M = BATCH * SEQ, DEPTH = 4, NCHUNK = SEQ / 64;
constexpr int HP = 5120;
constexpr int QOFF = 0, QMOFF = 1024, KOFF = 1536, VOFF = 2560, ZOFF = 3584;
constexpr int EB = 1536;
constexpr int NWAVES = 8;
constexpr float LOG2E = 1.4426950408889634f;
constexpr float LN_EPS = 1e-5f, INV_D = 1.0f / 1024.0f;
constexpr size_t MiB = 1u << 20;
constexpr size_t WS_CS = 0, WS_BW = 128 * 1024, WS_STATS = 256 * 1024, CTL_BYTES = 2 * MiB;
constexpr size_t WS_WIN = 2 * MiB, WS_WOUT = 42 * MiB, WS_WKV = 54 * MiB, WS_MEMB = 62 * MiB, WS_KVMEM = 64 * MiB, WS_XB = 72 * MiB, WS_H = 136 * MiB, WS_END = 456 * MiB;
static_assert(WS_STATS + (size_t)5 * M * 8 <= CTL_BYTES, "ctl");
constexpr int LDS_BYTES = 160000;
constexpr int LDS_BAR = 159744;
constexpr size_t WS_QCTR = 1700 * 1024;
constexpr size_t WS_BAR = 1536 * 1024;
constexpr int WAVE_LDS = 19488;
constexpr int VPITCH = 144;

__device__ __forceinline__ unsigned f2bf(float f) { unsigned u = __builtin_bit_cast(unsigned, f); return (u + 0x7fffu + ((u >> 16) & 1u)) >> 16; }
__device__ __forceinline__ unsigned pk2(float lo, float hi) { return f2bf(lo) | (f2bf(hi) << 16); }
__device__ __forceinline__ float bfr(float f) { return __builtin_bit_cast(float, f2bf(f) << 16); }
__device__ __forceinline__ float bflo(unsigned w) { return __builtin_bit_cast(float, w << 16); }
__device__ __forceinline__ float bfhi(unsigned w) { return __builtin_bit_cast(float, w & 0xffff0000u); }
__device__ __forceinline__ float silu(float z) { return z * __builtin_amdgcn_rcpf(1.0f + __builtin_amdgcn_exp2f(-z * LOG2E)); }
#define LDS_WAIT() asm volatile("s_waitcnt lgkmcnt(0)" ::: "memory")
__device__ __forceinline__ int lane_now() { int l; asm volatile("v_mbcnt_lo_u32_b32 %0, -1, 0\n\tv_mbcnt_hi_u32_b32 %0, -1, %0" : "=v"(l)); return l; }

struct TItem { const float* W; bf16_t* WT; const float* gv; const float* bv; float* cs; float* bw; int K, N, drow, k0, n0, scale; };
__device__ __forceinline__ void ti_load(const TItem& t, int lane, float (&w)[32]) {
#pragma unroll
    for (int i = 0; i < 32; ++i) { const int kk = 2 * i + (lane >> 5); w[i] = t.W[(size_t)(t.k0 + kk) * t.N + t.n0 + (lane & 31)]; }
}
__device__ __forceinline__ void ti_process(const TItem& t, LAS float* scr, int lane, const float (&wv)[32]) {
    float csp = 0.f, bwp = 0.f;
    if (t.scale) {
#pragma unroll
        for (int i = 0; i < 32; ++i) { const int kk = 2 * i + (lane >> 5); float w = wv[i]; const float gk = t.gv ? t.gv[t.k0 + kk] : 1.f, bk = t.bv ? t.bv[t.k0 + kk] : 0.f; bwp += w * bk; w *= gk; csp += bfr(w); scr[kk * 33 + (lane & 31)] = w; }
    } else {
#pragma unroll
        for (int i = 0; i < 32; ++i) { const int kk = 2 * i + (lane >> 5); scr[kk * 33 + (lane & 31)] = wv[i]; }
    }
    LDS_WAIT();
    const int c = lane & 7;
#pragma unroll
    for (int j = 0; j < 4; ++j) { const int n = (lane >> 3) + 8 * j; const LAS float* s = scr + (8 * c) * 33 + n;
        u32x4 o; o.x = pk2(s[0 * 33], s[1 * 33]); o.y = pk2(s[2 * 33], s[3 * 33]); o.z = pk2(s[4 * 33], s[5 * 33]); o.w = pk2(s[6 * 33], s[7 * 33]);
        *(u32x4*)(t.WT + (size_t)(t.drow + n) * t.K + t.k0 + 8 * c) = o; }
    LDS_WAIT();
    if (t.scale) { csp += __shfl_xor(csp, 32); bwp += __shfl_xor(bwp, 32);
        if (lane < 32) { unsafeAtomicAdd(t.cs + t.drow + lane, csp); unsafeAtomicAdd(t.bw + t.drow + lane, bwp); } }
}
__device__ __forceinline__ void row_to_bf16(const float* xrow, bf16_t* orow, int lane) {
    const f32x4* xr = (const f32x4*)xrow + lane; u32x2* o8 = (u32x2*)orow + lane;
#pragma unroll
    for (int j = 0; j < 4; ++j) { const f32x4 v = xr[64 * j]; u32x2 w; w.x = pk2(v[0], v[1]); w.y = pk2(v[2], v[3]); o8[64 * j] = w; }
}

struct Args { const float *x, *mem, *w_in, *w_kv, *w_out, *rel, *convw, *lng, *lnb; float* out; unsigned char* ws; int ph_lo, ph_hi; };

__device__ __forceinline__ void prologue(const Args& a, unsigned char* ws, LAS unsigned char* lds, int gw, int NGW, int wave, int lane) {
    LAS float* scr = (LAS float*)(lds + wave * WAVE_LDS);
    constexpr int I_IN = 16 * 160, I_OUT = 24 * 32, I_KV = 16 * 32;
    constexpr int NITEMS = DEPTH * (I_IN + I_OUT + I_KV);
    auto decode = [&](int it, TItem& t) {
        int r = it;
        if (r < DEPTH * I_IN) { const int l = r / I_IN, q = r % I_IN, kb = q / 160, nb = q % 160, n0 = nb * 32;
            const int dn = n0 < 1024 ? n0 : (n0 < 3072 ? n0 + 512 : (n0 < 3584 ? n0 - 2048 : n0));
            t.W = a.w_in + (size_t)l * D * HP; t.K = D; t.N = HP; t.WT = (bf16_t*)(ws + WS_WIN) + (size_t)l * HP * D; t.drow = dn; t.k0 = kb * 64; t.n0 = n0;
            t.gv = l ? a.lng + (l - 1) * D : nullptr; t.bv = l ? a.lnb + (l - 1) * D : nullptr; t.cs = (float*)(ws + WS_CS) + l * HP; t.bw = (float*)(ws + WS_BW) + l * HP; t.scale = 1; return; }
        r -= DEPTH * I_IN; t.gv = nullptr; t.bv = nullptr; t.cs = nullptr; t.bw = nullptr; t.scale = 0;
        if (r < DEPTH * I_OUT) { const int l = r / I_OUT, q = r % I_OUT, kb = q / 32, nb = q % 32;
            t.W = a.w_out + (size_t)l * EB * D; t.K = EB; t.N = D; t.WT = (bf16_t*)(ws + WS_WOUT) + (size_t)l * D * EB; t.drow = nb * 32; t.k0 = kb * 64; t.n0 = nb * 32; return; }
        r -= DEPTH * I_OUT;
        { const int l = r / I_KV, q = r % I_KV, kb = q / 32, nb = q % 32;
            t.W = a.w_kv + (size_t)l * D * D; t.K = D; t.N = D; t.WT = (bf16_t*)(ws + WS_WKV) + (size_t)l * D * D; t.drow = nb * 32; t.k0 = kb * 64; t.n0 = nb * 32; }
    };
    if (gw < NITEMS) {
        TItem cur; decode(gw, cur); float wc[32]; ti_load(cur, lane, wc);
        for (int it = gw; it < NITEMS; it += NGW) {
            TItem nxt = cur; float wn[32]; const bool more = it + NGW < NITEMS;
            if (more) { decode(it + NGW, nxt); ti_load(nxt, lane, wn); }
            ti_process(cur, scr, lane, wc);
            if (more) { cur = nxt;
#pragma unroll
                for (int i = 0; i < 32; ++i) wc[i] = wn[i]; }
        }
    }
    lane = lane_now();
    float* st0 = (float*)(ws + WS_STATS);
    for (int m = gw; m < M; m += 4 * NGW) {
        f32x4 v[4][4];
#pragma unroll
        for (int r = 0; r < 4; ++r)
#pragma unroll
            for (int j = 0; j < 4; ++j) v[r][j] = ((const f32x4*)(a.x + (size_t)(m + r * NGW) * D))[64 * j + lane];
#pragma unroll
        for (int r = 0; r < 4; ++r) { u32x2* o8 = (u32x2*)((bf16_t*)(ws + WS_XB) + (size_t)(m + r * NGW) * D) + lane;
#pragma unroll
            for (int j = 0; j < 4; ++j) { u32x2 w; w.x = pk2(v[r][j][0], v[r][j][1]); w.y = pk2(v[r][j][2], v[r][j][3]); o8[64 * j] = w; }
            if (lane == 0) { float c0 = 0.f, c1 = 1024.0f * (1.0f - LN_EPS); asm volatile("" : "+v"(c0), "+v"(c1));
                st0[2 * (size_t)(m + r * NGW)] = c0; st0[2 * (size_t)(m + r * NGW) + 1] = c1; } }
    }
    for (int m = gw; m < BATCH * 256; m += NGW) row_to_bf16(a.mem + (size_t)m * D, (bf16_t*)(ws + WS_MEMB) + (size_t)m * D, lane);
}

typedef short s16x4 __attribute__((ext_vector_type(4)));
typedef __bf16 bf2_t __attribute__((ext_vector_type(2)));
__device__ __forceinline__ unsigned cvtpk(float lo, float hi) { const f32x2 v = {lo, hi}; return __builtin_bit_cast(unsigned, __builtin_convertvector(v, bf2_t)); }
template <int DH, int KEYS, int NQ, bool BIAS, bool STAGE = true>
__device__ __forceinline__ void attn_task(const bf16_t* qbase, const bf16_t* kbase, const bf16_t* vbase, const bf16_t* zbase, bf16_t* ybase,
                                          int ldq, int ldkv, int ntiles, int jrot, int rel00, float scale, LAS unsigned char* kbuf, LAS unsigned char* vbuf, const LAS float* tab, int lane) {
    const int n = lane & 31, hh = lane >> 5;
    constexpr int KS = DH / 16, DB = DH / 32, PITCH = DH * 2 + 16, CPR = DH / 8  , RPI = 64 / CPR  , NP = KEYS / RPI;
    static_assert(KEYS == 32, "one 32-key row block per tile");
    const unsigned g0 = (unsigned)((lane / CPR) * ldkv + (lane % CPR) * 8), l0 = (unsigned)((lane / CPR) * PITCH + (lane % CPR) * 16);
    u32x4 kr[STAGE ? NP : 1], vr[STAGE ? NP : 1];
    if constexpr (STAGE) { const bf16_t* kt = kbase + (size_t)jrot * KEYS * ldkv; const bf16_t* vt = vbase + (size_t)jrot * KEYS * ldkv;
#pragma unroll
    for (int it = 0; it < NP; ++it) { kr[it] = *(const u32x4*)(kt + (size_t)it * RPI * ldkv + g0); vr[it] = *(const u32x4*)(vt + (size_t)it * RPI * ldkv + g0); } }
    bf16x8 qf[NQ][KS];
#pragma unroll
    for (int cq = 0; cq < NQ; ++cq)
#pragma unroll
        for (int ks = 0; ks < KS; ++ks) qf[cq][ks] = *(const bf16x8*)(qbase + (size_t)(32 * cq + n) * ldq + ks * 16 + hh * 8);
    f32x16 O[NQ][DB];
#pragma unroll
    for (int cq = 0; cq < NQ; ++cq)
#pragma unroll
        for (int d = 0; d < DB; ++d)
#pragma unroll
            for (int i = 0; i < 16; ++i) O[cq][d][i] = 0.f;
    float mrun[NQ], lsum[NQ];
#pragma unroll
    for (int cq = 0; cq < NQ; ++cq) { mrun[cq] = -1e30f; lsum[cq] = 0.f; }
    if constexpr (STAGE) { LDS_WAIT();
#pragma unroll
    for (int it = 0; it < NP; ++it) { *(LAS u32x4*)(kbuf + l0 + it * RPI * PITCH) = kr[it]; *(LAS u32x4*)(vbuf + l0 + it * RPI * PITCH) = vr[it]; } }
    const LAS unsigned char* kl0 = kbuf + n * PITCH + hh * 16;
    const LAS unsigned char* vl0 = vbuf + (4 * hh + ((lane & 15) >> 2)) * PITCH + (16 * ((lane >> 4) & 1) + 4 * (lane & 3)) * 2;
    __builtin_amdgcn_s_waitcnt(0x0F70);
    int j = jrot;
    for (int st = 0; st < ntiles; ++st) {
        const bool more = st + 1 < ntiles; const int jn = (j + 1 == ntiles) ? 0 : j + 1;
        const LAS unsigned char* kl = STAGE ? kl0 : kl0 + j * KEYS * PITCH; const LAS unsigned char* vl = STAGE ? vl0 : vl0 + j * KEYS * PITCH;
        if (STAGE && more) { const bf16_t* kt = kbase + (size_t)jn * KEYS * ldkv; const bf16_t* vt = vbase + (size_t)jn * KEYS * ldkv;
#pragma unroll
            for (int it = 0; it < NP; ++it) { kr[it] = *(const u32x4*)(kt + (size_t)it * RPI * ldkv + g0); vr[it] = *(const u32x4*)(vt + (size_t)it * RPI * ldkv + g0); } }
        bf16x8 kf[KS];
#pragma unroll
        for (int ks = 0; ks < KS; ++ks) kf[ks] = *(const LAS bf16x8*)(kl + ks * 32);
        union { bf16x8 v; s16x4 h[2]; } vf[2][DB];
        constexpr bool EARLY_V = (DH == 64);
#define ATT_LOAD_VF() _Pragma("unroll") for (int s = 0; s < 2; ++s) _Pragma("unroll") for (int d = 0; d < DB; ++d) { \
                vf[s][d].h[0] = __builtin_amdgcn_ds_read_tr16_b64_v4i16((LAS s16x4*)(vl + (16 * s) * PITCH + d * 64)); \
                vf[s][d].h[1] = __builtin_amdgcn_ds_read_tr16_b64_v4i16((LAS s16x4*)(vl + (16 * s + 8) * PITCH + d * 64)); }
        if (EARLY_V) { ATT_LOAD_VF() }
        const int rel0 = rel00 - j * KEYS;
        const bool elementwise = BIAS && rel0 < 160; const float bc = (BIAS && !elementwise) ? tab[0] : 0.f;
        f32x16 SS[NQ];
#pragma unroll
        for (int cq = 0; cq < NQ; ++cq)
#pragma unroll
            for (int i = 0; i < 16; ++i) SS[cq][i] = 0.f;
#pragma unroll
        for (int ks = 0; ks < KS; ++ks)
#pragma unroll
            for (int cq = 0; cq < NQ; ++cq) SS[cq] = __builtin_amdgcn_mfma_f32_32x32x16_bf16(kf[ks], qf[cq][ks], SS[cq], 0, 0, 0);
#pragma unroll
        for (int cq = 0; cq < NQ; ++cq) {
            f32x16 S = SS[cq];
            if (BIAS && elementwise) { const LAS float* tp = tab + (191 - rel0 - 32 * cq - n + 4 * hh);
#pragma unroll
                for (int i = 0; i < 16; ++i) S[i] = S[i] * scale + tp[(i & 3) + 8 * (i >> 2)]; }
            float mx = S[0];
#pragma unroll
            for (int i = 1; i < 16; ++i) mx = fmaxf(mx, S[i]);
            mx = fmaxf(mx, __shfl_xor(mx, 32));
            if (!elementwise) mx = mx * scale + bc;
            const bool grew = mx > mrun[cq] + 8.0f; const float mnew = grew ? mx : mrun[cq], alpha = __builtin_amdgcn_exp2f(mrun[cq] - mnew);
            mrun[cq] = mnew;
            float ps = 0.f;
            if (elementwise) {
#pragma unroll
                for (int i = 0; i < 16; ++i) { S[i] = __builtin_amdgcn_exp2f(S[i] - mnew); ps += S[i]; }
            } else { const float cc = bc - mnew;
#pragma unroll
                for (int i = 0; i < 16; ++i) { S[i] = __builtin_amdgcn_exp2f(S[i] * scale + cc); ps += S[i]; }
            }
            lsum[cq] = lsum[cq] * alpha + ps;
            if (__builtin_amdgcn_ballot_w64(grew) != 0ull) {
#pragma unroll
                for (int d = 0; d < DB; ++d)
#pragma unroll
                    for (int i = 0; i < 16; ++i) O[cq][d][i] *= alpha;
            }
            union { bf16x8 v; unsigned u[4]; } pf[2];
#pragma unroll
            for (int e = 0; e < 4; ++e) { pf[0].u[e] = cvtpk(S[2 * e], S[2 * e + 1]); pf[1].u[e] = cvtpk(S[8 + 2 * e], S[9 + 2 * e]); }
            if (!EARLY_V) { ATT_LOAD_VF() }
#pragma unroll
            for (int s = 0; s < 2; ++s)
#pragma unroll
                for (int d = 0; d < DB; ++d) O[cq][d] = __builtin_amdgcn_mfma_f32_32x32x16_bf16(vf[s][d].v, pf[s].v, O[cq][d], 0, 0, 0);
        }
        if (STAGE && more) {
            LDS_WAIT();
#pragma unroll
            for (int it = 0; it < NP; ++it) { *(LAS u32x4*)(kbuf + l0 + it * RPI * PITCH) = kr[it]; *(LAS u32x4*)(vbuf + l0 + it * RPI * PITCH) = vr[it]; }
        }
        j = jn;
    }
    float inv[NQ];
#pragma unroll
    for (int cq = 0; cq < NQ; ++cq) inv[cq] = 1.0f / (lsum[cq] + __shfl_xor(lsum[cq], 32));
    if constexpr (STAGE) {
        constexpr int OP = DH * 4 + 16, ROWS = 32 * NQ, NIT = ROWS * DH / 8 / 64, CPRO = DH / 8;
        static_assert(ROWS * OP <= 18432, "O tile fits the wave's K+V buffers");
        LDS_WAIT();
#pragma unroll
        for (int cq = 0; cq < NQ; ++cq)
#pragma unroll
            for (int d = 0; d < DB; ++d)
#pragma unroll
                for (int g4 = 0; g4 < 4; ++g4) { const f32x4 v = {O[cq][d][4 * g4] * inv[cq], O[cq][d][4 * g4 + 1] * inv[cq], O[cq][d][4 * g4 + 2] * inv[cq], O[cq][d][4 * g4 + 3] * inv[cq]};
                    *(LAS f32x4*)(kbuf + (32 * cq + n) * OP + (32 * d + 8 * g4 + 4 * hh) * 4) = v; }
        LDS_WAIT();
#pragma unroll
        for (int hb = 0; hb < NIT; hb += 4) { u32x4 zz[4];
#pragma unroll
        for (int it = 0; it < 4; ++it) { const int id = (hb + it) * 64 + lane, row = id / CPRO, chn = id % CPRO; zz[it] = *(const u32x4*)(zbase + (size_t)row * ldq + chn * 8); }
#pragma unroll
        for (int it = hb; it < hb + 4; ++it) { const int id = it * 64 + lane, row = id / CPRO, chn = id % CPRO;
            const f32x4 o0 = *(const LAS f32x4*)(kbuf + row * OP + chn * 32), o1 = *(const LAS f32x4*)(kbuf + row * OP + chn * 32 + 16); const u32x4 z = zz[it - hb];
            u32x4 w; w.x = cvtpk(o0[0] * silu(bflo(z.x)), o0[1] * silu(bfhi(z.x))); w.y = cvtpk(o0[2] * silu(bflo(z.y)), o0[3] * silu(bfhi(z.y)));
                     w.z = cvtpk(o1[0] * silu(bflo(z.z)), o1[1] * silu(bfhi(z.z))); w.w = cvtpk(o1[2] * silu(bflo(z.w)), o1[3] * silu(bfhi(z.w)));
            *(u32x4*)(ybase + (size_t)row * ldq + chn * 8) = w; } }
        LDS_WAIT();
    } else {
        static_assert(NQ == 1 && !BIAS, "non-staged form: one query block, no bias table"); LAS unsigned char* otb = (LAS unsigned char*)tab;
#pragma unroll
        for (int d = 0; d < DB; ++d) {
            u32x4 zz[2];
#pragma unroll
            for (int i2 = 0; i2 < 2; ++i2) { const int row = i2 * 16 + (lane >> 2), chn = lane & 3; zz[i2] = *(const u32x4*)(zbase + (size_t)row * ldq + 32 * d + chn * 8); }
            LDS_WAIT();
#pragma unroll
            for (int g4 = 0; g4 < 4; ++g4) { u32x2 w; w.x = cvtpk(O[0][d][4 * g4] * inv[0], O[0][d][4 * g4 + 1] * inv[0]); w.y = cvtpk(O[0][d][4 * g4 + 2] * inv[0], O[0][d][4 * g4 + 3] * inv[0]);
                *(LAS u32x2*)(otb + n * 80 + (8 * g4 + 4 * hh) * 2) = w; }
            LDS_WAIT();
#pragma unroll
            for (int i2 = 0; i2 < 2; ++i2) { const int row = i2 * 16 + (lane >> 2), chn = lane & 3; const u32x4 o = *(const LAS u32x4*)(otb + row * 80 + chn * 16); const u32x4 z = zz[i2];
                u32x4 w; w.x = cvtpk(bflo(o.x) * silu(bflo(z.x)), bfhi(o.x) * silu(bfhi(z.x))); w.y = cvtpk(bflo(o.y) * silu(bflo(z.y)), bfhi(o.y) * silu(bfhi(z.y)));
                         w.z = cvtpk(bflo(o.z) * silu(bflo(z.z)), bfhi(o.z) * silu(bfhi(z.z))); w.w = cvtpk(bflo(o.w) * silu(bflo(z.w)), bfhi(o.w) * silu(bfhi(z.w)));
                *(u32x4*)(ybase + (size_t)row * ldq + 32 * d + chn * 8) = w; }
        }
        LDS_WAIT();
    }
}

__device__ __forceinline__ void conv_task(bf16_t* h, const float* cw, int b, int c, int part, int lane) {
    const int th = part >> 1, ch = (part & 1) * 512 + lane * 8, t0 = c * 64 + th * 32;
    float w0[8], w1[8], w2[8], um2[8], um1[8];
#pragma unroll
    for (int e = 0; e < 8; ++e) { w0[e] = cw[ch + e]; w1[e] = cw[D + ch + e]; w2[e] = cw[2 * D + ch + e]; um2[e] = 0.f; um1[e] = 0.f; }
    bf16_t* row0 = h + (size_t)(b * SEQ + t0) * HP;
    if (t0 >= 2) {
        const u32x4 a2 = *(const u32x4*)(row0 - 2 * (size_t)HP + KOFF + ch), b2 = *(const u32x4*)(row0 - 2 * (size_t)HP + VOFF + ch);
        const u32x4 a1 = *(const u32x4*)(row0 - (size_t)HP + KOFF + ch), b1 = *(const u32x4*)(row0 - (size_t)HP + VOFF + ch);
#pragma unroll
        for (int e = 0; e < 4; ++e) { um2[2 * e] = bflo(a2[e]) * bflo(b2[e]); um2[2 * e + 1] = bfhi(a2[e]) * bfhi(b2[e]); um1[2 * e] = bflo(a1[e]) * bflo(b1[e]); um1[2 * e + 1] = bfhi(a1[e]) * bfhi(b1[e]); }
    }
    u32x4 na[4], nb[4], np[4], nz[4];
#pragma unroll
    for (int r = 0; r < 4; ++r) { bf16_t* row = row0 + (size_t)r * HP; na[r] = *(const u32x4*)(row + KOFF + ch); nb[r] = *(const u32x4*)(row + VOFF + ch); np[r] = *(const u32x4*)(row + QOFF + ch); nz[r] = *(const u32x4*)(row + ZOFF + ch); }
    for (int tb = 0; tb < 32; tb += 4) {
        u32x4 pa[4], pb[4], pp[4], pz[4];
#pragma unroll
        for (int r = 0; r < 4; ++r) { pa[r] = na[r]; pb[r] = nb[r]; pp[r] = np[r]; pz[r] = nz[r]; }
        if (tb + 4 < 32) {
#pragma unroll
            for (int r = 0; r < 4; ++r) { bf16_t* row = row0 + (size_t)(tb + 4 + r) * HP; na[r] = *(const u32x4*)(row + KOFF + ch); nb[r] = *(const u32x4*)(row + VOFF + ch); np[r] = *(const u32x4*)(row + QOFF + ch); nz[r] = *(const u32x4*)(row + ZOFF + ch); } }
#pragma unroll
        for (int r = 0; r < 4; ++r) { float u[8]; u32x4 o;
#pragma unroll
            for (int e = 0; e < 4; ++e) { u[2 * e] = bflo(pa[r][e]) * bflo(pb[r][e]); u[2 * e + 1] = bfhi(pa[r][e]) * bfhi(pb[r][e]); }
#pragma unroll
            for (int e = 0; e < 4; ++e) { const float c0 = w0[2 * e] * um2[2 * e] + w1[2 * e] * um1[2 * e] + w2[2 * e] * u[2 * e], c1 = w0[2 * e + 1] * um2[2 * e + 1] + w1[2 * e + 1] * um1[2 * e + 1] + w2[2 * e + 1] * u[2 * e + 1];
                o[e] = pk2(bflo(pp[r][e]) * c0 * silu(bflo(pz[r][e])), bfhi(pp[r][e]) * c1 * silu(bfhi(pz[r][e]))); }
            *(u32x4*)(row0 + (size_t)(tb + r) * HP + QOFF + ch) = o;
#pragma unroll
            for (int e = 0; e < 8; ++e) { um2[e] = um1[e]; um1[e] = u[e]; } }
    }
}

__device__ __forceinline__ void mixer_phase(const Args& a, unsigned char* ws, int layer, LAS unsigned char* lds, int gw, int NGW, int wave, int lane) {
    LAS unsigned char* kbuf = lds + wave * WAVE_LDS; LAS unsigned char* vbuf = kbuf + 9216; LAS float* tab = (LAS float*)(kbuf + 18432);
    bf16_t* h = (bf16_t*)(ws + WS_H); const bf16_t* kvm = (const bf16_t*)(ws + WS_KVMEM);
    const bool is_attn = (layer & 1) == 0;
    const int LW = NGW / 8, x = gw / LW;
    const int b = x >> 1, cbeg = (x & 1) * 64;
    unsigned* ctr = (unsigned*)(ws + WS_QCTR) + (layer * 8 + x) * 64;
    const int n_mix = is_attn ? 1024 : 256, ntask = n_mix;
    {
        const int wgx = (gw % LW) >> 3, mh = wgx & 3, grp = wgx >> 2, tid = wave * 64 + lane;
        LAS unsigned char* Kl = lds; LAS unsigned char* Vl = lds + 256 * 272;
        const bf16_t* kb = kvm + (size_t)b * 256 * 4096 + layer * 1024 + mh * 128;
        for (int kv = 0; kv < 2; ++kv) { u32x4 tk[8];
#pragma unroll
            for (int i = 0; i < 8; ++i) { const int id = tid + 512 * i, row = id >> 4, chn = id & 15; tk[i] = *(const u32x4*)(kb + kv * 512 + (size_t)row * 4096 + chn * 8); }
#pragma unroll
            for (int i = 0; i < 8; ++i) { const int id = tid + 512 * i, row = id >> 4, chn = id & 15; *(LAS u32x4*)((kv ? Vl : Kl) + row * 272 + chn * 16) = tk[i]; } }
        __syncthreads();
        for (int i = 0; i < 2; ++i) { int lane; asm volatile("v_mbcnt_lo_u32_b32 %0, -1, 0\n\tv_mbcnt_hi_u32_b32 %0, -1, %0" : "=v"(lane)); const int qbi = grp * 16 + wave * 2 + i, c = cbeg + (qbi >> 1), qh = qbi & 1; const size_t R0 = (size_t)b * SEQ + c * 64 + qh * 32;
            bf16_t* qb = h + R0 * HP + QMOFF + mh * 128;
            attn_task<128, 32, 1, false, false>(qb, nullptr, nullptr, h + R0 * HP + ZOFF + 1024 + mh * 128, qb, HP, 4096, 8, 0, 0, 0.08838834764831845f * LOG2E, Kl, Vl, (const LAS float*)(lds + 139264 + wave * 2560), lane); }
        __syncthreads();
    }
    for (;;) {
        int lane; asm volatile("v_mbcnt_lo_u32_b32 %0, -1, 0\n\tv_mbcnt_hi_u32_b32 %0, -1, %0" : "=v"(lane));
        unsigned tq = 0; if (lane == 0) tq = __hip_atomic_fetch_add(ctr, 1u, __ATOMIC_RELAXED, __HIP_MEMORY_SCOPE_AGENT);
        const int t = __builtin_amdgcn_readfirstlane((int)tq);
        if (t >= ntask) break;
        if (is_attn) {
            const int head = t & 15, c = cbeg + 63 - (t >> 4), jlo = c < 8 ? 0 : c - 8; const size_t R0 = (size_t)b * SEQ + c * 64;
            const float* rb = a.rel + ((size_t)(layer >> 1) * 16 + head) * 257;
            LDS_WAIT();
#pragma unroll
            for (int k = 0; k < 4; ++k) { const int xx = lane + 64 * k, rel = 191 - xx; tab[xx] = rb[(rel > 128 ? 128 : rel) + 128] * LOG2E; }
            LDS_WAIT();
            bf16_t* qb = h + R0 * HP + QOFF + head * 64; const bf16_t* kb = h + ((size_t)b * SEQ + jlo * 64) * HP + KOFF + head * 64;
            attn_task<64, 32, 2, true>(qb, kb, kb + (VOFF - KOFF), h + R0 * HP + ZOFF + head * 64, qb, HP, HP, 2 * (c - jlo + 1), c >= 8 ? (18 - (2 * (c - 8)) % 18) % 18 : 0, 64 * (c - jlo), 0.125f * LOG2E, kbuf, vbuf, tab, lane);
        } else {
            conv_task(h, a.convw + (size_t)(layer >> 1) * 3 * D, b, cbeg + (t >> 2), t & 3, lane);
        }
    }
}

#define XB_TMO      128
#define XB_XCNT(j)  (256  + 64 * (j))
#define XB_XSUB(j)  (1280 + 64 * (j))
#define XB_XGEN(j)  (2304 + 64 * (j))
#define XB_TOP      3328
#define XB_TOPGEN   3392
#define XCD_BAR_WORDS 3456
#define XB_SPIN_CAP (1u << 18)

__device__ __forceinline__ unsigned xb_ld(unsigned* p)              { return __hip_atomic_load(p, __ATOMIC_RELAXED, __HIP_MEMORY_SCOPE_AGENT); }
__device__ __forceinline__ unsigned xb_add(unsigned* p, unsigned v) { return __hip_atomic_fetch_add(p, v, __ATOMIC_RELAXED, __HIP_MEMORY_SCOPE_AGENT); }
__device__ __forceinline__ unsigned xb_xcc_id() { return (unsigned)__builtin_amdgcn_s_getreg((3 << 11) | 20) & 0xFu; }
#define XB_SPIN(cond, bar) do { unsigned _sp = 0; while (cond) { __builtin_amdgcn_s_sleep(1); \
    if ((++_sp & 255u) == 0u) { if (xb_ld(&(bar)[XB_TMO])) break; if (_sp > XB_SPIN_CAP) { atomicAdd(&(bar)[XB_TMO], 1u); break; } } } } while (0)

struct XcdBarrier {
    unsigned* bar; unsigned x; unsigned wv;
    volatile LAS unsigned* st;
};

__device__ __forceinline__ XcdBarrier xcd_barrier_post(unsigned* bar, volatile LAS unsigned* st) {
    XcdBarrier b; b.bar = bar; b.x = xb_xcc_id(); b.st = st;
    if (threadIdx.x == 0) (void)xb_add(&bar[XB_XCNT(b.x)], 1u);
    return b;
}
__device__ __forceinline__ void xcd_barrier_complete(unsigned* bar, unsigned x, unsigned& nloc, unsigned& nx) {
    const unsigned G = gridDim.x * gridDim.y * gridDim.z;
    unsigned sum, cnt, mine, sp = 0u;
    for (;;) {
        sum = 0u; cnt = 0u; mine = 0u;
#pragma unroll
        for (unsigned j = 0; j < 16; ++j) { const unsigned c = xb_ld(&bar[XB_XCNT(j)]); sum += c; cnt += (c > 0u) ? 1u : 0u; mine = (j == x) ? c : mine; }
        if (sum == G) break;
        __builtin_amdgcn_s_sleep(1);
        if ((++sp & 255u) == 0u) { if (xb_ld(&bar[XB_TMO])) break; if (sp > XB_SPIN_CAP) { atomicAdd(&bar[XB_TMO], 1u); break; } }
    }
    nloc = mine > 0u ? mine : 1u; nx = cnt > 0u ? cnt : 1u;
}

__device__ __forceinline__ void xcd_barrier(const XcdBarrier& b) {
    asm volatile("s_waitcnt vmcnt(0)" ::: "memory");
    __syncthreads();
    if (b.wv == 0 && lane_now() == 0) {
        unsigned* bar = b.bar;
        __builtin_amdgcn_s_waitcnt(0);
        unsigned nloc = b.st[0], nx = b.st[1];
        if (nloc == 0u) { xcd_barrier_complete(bar, b.x, nloc, nx); b.st[0] = nloc; b.st[1] = nx; }
        const unsigned old = xb_add(&bar[XB_XSUB(b.x)], 1u);
        const unsigned gen = old / nloc;
        if (old + 1u == (gen + 1u) * nloc) {
            __builtin_amdgcn_fence(__ATOMIC_RELEASE, "agent");
            asm volatile("s_waitcnt vmcnt(0)" ::: "memory");
            const unsigned og = xb_add(&bar[XB_TOP], 1u);
            const unsigned tg = og / nx;
            if (og + 1u == (tg + 1u) * nx) xb_add(&bar[XB_TOPGEN], 1u);
            else XB_SPIN(xb_ld(&bar[XB_TOPGEN]) == tg, bar);
            __builtin_amdgcn_fence(__ATOMIC_ACQUIRE, "agent");
            xb_add(&bar[XB_XGEN(b.x)], 1u);
            asm volatile("s_waitcnt vmcnt(0)" ::: "memory");
        } else {
            XB_SPIN(xb_ld(&bar[XB_XGEN(b.x)]) == gen, bar);
            __builtin_amdgcn_fence(__ATOMIC_ACQUIRE, "agent");
            asm volatile("s_waitcnt vmcnt(0)" ::: "memory");
        }
    }
    __syncthreads();
}

__global__ void __launch_bounds__(NWAVES * 64, 2) fwd_kernel(Args a) {
    extern __shared__ __attribute__((aligned(16))) unsigned char lds_raw[];
    LAS unsigned char* lds = (LAS unsigned char*)lds_raw;
    if (threadIdx.x < 64) ((LAS unsigned*)(lds + LDS_BAR))[threadIdx.x] = 0u;
    __syncthreads();
    XcdBarrier bar = xcd_barrier_post((unsigned*)(a.ws + WS_BAR), (volatile LAS unsigned*)(lds + LDS_BAR));
    const int wave_sg = __builtin_amdgcn_readfirstlane((int)(threadIdx.x >> 6)); bar.wv = (unsigned)wave_sg;
    for (int ph0 = a.ph_lo; ph0 < a.ph_hi; ++ph0) {
        int ph = ph0; asm volatile("" : "+s"(ph));
        size_t wzero = 0; asm volatile("" : "+s"(wzero)); unsigned char* ws = a.ws + wzero;
        const int wave = wave_sg;
#define lane lane_now()
#define tid (wave_sg * 64 + lane_now())
        const int G = gridDim.x, bx = blockIdx.x, vcu = (G % 8 == 0) ? (bx % 8) * (G / 8) + bx / 8 : bx;
        const int gw = vcu * NWAVES + wave, NGW = G * NWAVES;
        bf16_t* h = (bf16_t*)(ws + WS_H); bf16_t* xb = (bf16_t*)(ws + WS_XB);
        float* stats = (float*)(ws + WS_STATS);
        if (ph == 0) prologue(a, ws, lds, gw, NGW, wave, lane);
        else if (ph == 13) {
            const float* st = stats + (size_t)4 * M * 2; const float* g = a.lng + 3 * D; const float* bb = a.lnb + 3 * D;
            f32x4 gg[4], b4[4];
#pragma unroll
            for (int j = 0; j < 4; ++j) { gg[j] = ((const f32x4*)g)[64 * j + lane]; b4[j] = ((const f32x4*)bb)[64 * j + lane]; }
            for (int m = gw; m < M; m += 4 * NGW) {
                f32x4 v[4][4]; f32x2 sr[4];
#pragma unroll
                for (int r = 0; r < 4; ++r) { sr[r] = *(const f32x2*)(st + 2 * (size_t)(m + r * NGW));
#pragma unroll
                    for (int j = 0; j < 4; ++j) v[r][j] = ((const f32x4*)(a.out + (size_t)(m + r * NGW) * D))[64 * j + lane]; }
#pragma unroll
                for (int r = 0; r < 4; ++r) { const float mu = sr[r].x * INV_D, var = sr[r].y * INV_D - mu * mu, rstd = rsqrtf(var + LN_EPS);
                    f32x4* xr = (f32x4*)(a.out + (size_t)(m + r * NGW) * D) + lane;
#pragma unroll
                    for (int j = 0; j < 4; ++j) xr[64 * j] = (v[r][j] - mu) * rstd * gg[j] + b4[j]; }
            }
        } else if (ph == 1 || (ph - 2) % 3 == 2) {
            const int l = ph == 1 ? 0 : (ph - 2) / 3 + 1;
            if (ph == 1) { pg8::Gemm g{(const bf16_t*)(ws + WS_MEMB), (const bf16_t*)(ws + WS_WKV), BATCH * 256, 4096, D, D}; pg8::StaticOrder S; S.init(BATCH * 256, 4096, G, bx);
                pg8::EpiPlain E{(bf16_t*)(ws + WS_KVMEM), 4096};
                pg8::gemm_phase<pg8::EpiPlain, pg8::StaticOrder, true, true>(lds, g, S, E, tid); }
            pg8::Gemm g{xb, (const bf16_t*)(ws + WS_WIN) + (size_t)l * HP * D, M, HP, D, D}; pg8::StaticOrder S; S.init(M, HP, G, bx);
            pg8::EpiIn E{h, HP, stats + (size_t)l * M * 2, (const float*)(ws + WS_CS) + l * HP, (const float*)(ws + WS_BW) + l * HP};
            pg8::gemm_phase<pg8::EpiIn, pg8::StaticOrder, true, true>(lds, g, S, E, wave_sg * 64 + lane_now());
        } else if ((ph - 2) % 3 == 0) {
            mixer_phase(a, ws, (ph - 2) / 3, lds, gw, NGW, wave, lane);
        } else {
            const int l = (ph - 2) / 3;
            pg8::Gemm g{h, (const bf16_t*)(ws + WS_WOUT) + (size_t)l * D * EB, M, D, EB, HP}; pg8::StaticOrder S; S.init(M, D, G, bx);
            pg8::EpiOut E{l == 0 ? a.x : (l == 3 ? a.out : nullptr), l >= 2 ? a.out : nullptr, xb, stats + (size_t)l * M * 2, stats + (size_t)(l + 1) * M * 2, l ? a.lng + (l - 1) * D : nullptr, l ? a.lnb + (l - 1) * D : nullptr, l < 3 ? 1 : 0};
            pg8::gemm_phase<pg8::EpiOut, pg8::StaticOrder, true, true>(lds, g, S, E, wave_sg * 64 + lane_now());
        }
        if (ph + 1 < a.ph_hi) { if (a.ph_hi > 1000) cg::this_grid().sync();
            { XcdBarrier bb = bar; size_t bz = 0; asm volatile("" : "+s"(bz)); bb.bar = bar.bar + bz; xcd_barrier(bb); } }
    }
#undef lane
#undef tid
}

extern "C" void kernel_launch(void* const* d_in, const int* in_sizes, int n_in, void* d_out, int out_size, void* d_ws, size_t ws_size, hipStream_t stream) {
    static int grid = 0;
    if (grid == 0) {
        if (n_in != 9 || out_size != M * D || ws_size < WS_END) { fprintf(stderr, "kernel_launch: unexpected shapes (n_in %d out %d ws %zu)\n", n_in, out_size, ws_size); grid = -1; return; }
        int dev = 0, cus = 0, per_cu = 0;
        hipGetDevice(&dev); hipDeviceGetAttribute(&cus, hipDeviceAttributeMultiprocessorCount, dev);
        if (hipFuncSetAttribute((const void*)fwd_kernel, hipFuncAttributeMaxDynamicSharedMemorySize, LDS_BYTES) != hipSuccess) { fprintf(stderr, "kernel_launch: hipFuncSetAttribute failed\n"); grid = -1; return; }
        if (hipOccupancyMaxActiveBlocksPerMultiprocessor(&per_cu, (const void*)fwd_kernel, NWAVES * 64, LDS_BYTES) != hipSuccess || per_cu < 1) { fprintf(stderr, "kernel_launch: occupancy query says %d\n", per_cu); per_cu = 1; }
        (void)hipGetLastError();
        grid = cus;
    }
    if (grid < 0) return;
    hipMemsetAsync((char*)d_ws, 0, CTL_BYTES, stream);
    Args a{};
    a.x = (const float*)d_in[0]; a.mem = (const float*)d_in[1]; a.w_in = (const float*)d_in[2]; a.w_kv = (const float*)d_in[3]; a.w_out = (const float*)d_in[4];
    a.rel = (const float*)d_in[5]; a.convw = (const float*)d_in[6]; a.lng = (const float*)d_in[7]; a.lnb = (const float*)d_in[8];
    a.out = (float*)d_out; a.ws = (unsigned char*)d_ws;
#if MK_MULTI
    for (int ph = 0; ph < 14; ++ph) { a.ph_lo = ph; a.ph_hi = ph + 1; hipLaunchKernelGGL(fwd_kernel, dim3(grid), dim3(NWAVES * 64), LDS_BYTES, stream, a); }
#else
    a.ph_lo = 0; a.ph_hi = 14;
    void* args[] = {&a};
    hipError_t e = hipLaunchCooperativeKernel((const void*)fwd_kernel, dim3(grid), dim3(NWAVES * 64), args, LDS_BYTES, stream);
    if (e != hipSuccess) fprintf(stderr, "cooperative launch failed: %s (grid %d)\n", hipGetErrorString(e), grid);
#endif
}
```

```cpp
#include <hip/hip_runtime.h>
#include <hip/hip_cooperative_groups.h>
#include <cstdio>
#include <cstdint>
namespace cg = cooperative_groups;
#ifndef MK_MULTI
#define MK_MULTI 0
#endif
namespace pg8 {
#define PG8_LAS __attribute__((address_space(3)))
typedef unsigned short bf16_t;
typedef short bf16x8 __attribute__((ext_vector_type(8)));
typedef float f32x4 __attribute__((ext_vector_type(4)));
typedef unsigned u32x4 __attribute__((ext_vector_type(4)));
constexpr int BM = 256, BK = 64, HALF = 128, HTB = HALF * BK * 2  , STAGE_BYTES = 8 * HTB, NXCD = 8, WGM = 8;

__host__ __device__ __forceinline__ int lds_byte(int r, int c) { const int st = (r >> 4) * 2 + (c >> 5), rr = r & 15, cc = c & 31, ob = rr * 64 + cc * 2; return st * 1024 + (ob ^ (((ob >> 9) & 1) << 5)); }
__host__ __device__ __forceinline__ void stage_rc(int b, int& R, int& C) { const int st = b / 1024, sb = b % 1024, swz = sb ^ (((sb >> 9) & 1) << 5); R = (st >> 1) * 16 + swz / 64; C = (st & 1) * 32 + (swz % 64) / 2; }
__host__ __device__ __forceinline__ int perm32(int rho) { const int n = rho >> 4, i = rho & 15; return 8 * (i >> 2) + 4 * n + (i & 3); }

struct Unit { int pm, pn; };

struct StaticOrder {
    int nM, nN, nwg, G, c;
    __host__ __device__ void init(int M, int N, int G_, int c_) { nM = M / BM; nN = N / BM; nwg = nM * nN; G = G_; c = c_; }
    __host__ __device__ bool next(int i, Unit& u) const {
        const long L = (long)i * G + c; if (L >= nwg) return false;
        int wgid = (int)L; { const int q = nwg / NXCD, r = nwg % NXCD, xcd = wgid % NXCD, off = wgid / NXCD; wgid = (xcd < r ? xcd * (q + 1) : r * (q + 1) + (xcd - r) * q) + off; }
        const int nig = WGM * nN, gid = wgid / nig, fm = gid * WGM, gsz = (nM - fm) < WGM ? (nM - fm) : WGM;
        u.pm = fm + ((wgid % nig) % gsz); u.pn = (wgid % nig) / gsz; return true;
    }
    __device__ __forceinline__ void a_ready(const Unit&) const {}
    __device__ __forceinline__ void done(const Unit&) const {}
};

struct Gemm { const bf16_t* A; const bf16_t* Bt; int M, N, K, lda; };
__device__ __forceinline__ unsigned cvt_pk_bf16(float lo, float hi) { unsigned r; asm volatile("v_cvt_pk_bf16_f32 %0, %1, %2" : "=v"(r) : "v"(lo), "v"(hi)); return r; }
typedef float f32x2 __attribute__((ext_vector_type(2)));
constexpr float LN_EPS = 1e-5f, INV_D = 1.0f / 1024.0f, DN_ALPHA = 1.681792830507429f;

struct EpiPlain {
    static constexpr bool PERM = true, AFTER_DRAIN = false;
    bf16_t* O; int ldc;
    __device__ __forceinline__ void operator()(const f32x4 (&acc)[2][2][4][2], const Unit& u, int wr, int wc, int fr, int fq) const {
        const int row0 = u.pm * BM + wr * 64 + fr, col0 = u.pn * BM + wc * 32 + 8 * fq;
#pragma unroll
        for (int ai = 0; ai < 2; ++ai)
#pragma unroll
            for (int m = 0; m < 4; ++m) { bf16_t* rowp = O + (size_t)(row0 + ai * HALF + m * 16) * ldc + col0;
#pragma unroll
                for (int bj = 0; bj < 2; ++bj) { const f32x4 v0 = acc[ai][bj][m][0], v1 = acc[ai][bj][m][1];
                    u32x4 w; w.x = cvt_pk_bf16(v0[0], v0[1]); w.y = cvt_pk_bf16(v0[2], v0[3]); w.z = cvt_pk_bf16(v1[0], v1[1]); w.w = cvt_pk_bf16(v1[2], v1[3]);
                    *(u32x4*)(rowp + bj * HALF) = w; } }
    }
};
struct EpiIn {
    static constexpr bool PERM = true, AFTER_DRAIN = false;
    bf16_t* O; int ldc; const float* stats; const float* cs; const float* bw;
    __device__ __forceinline__ void operator()(const f32x4 (&acc)[2][2][4][2], const Unit& u, int wr, int wc, int fr, int fq) const {
        const int row0 = u.pm * BM + wr * 64 + fr, col0 = u.pn * BM + wc * 32 + 8 * fq;
        f32x2 st[2][4];
#pragma unroll
        for (int ai = 0; ai < 2; ++ai)
#pragma unroll
            for (int m = 0; m < 4; ++m) st[ai][m] = *(const f32x2*)(stats + 2 * (size_t)(row0 + ai * HALF + m * 16));
        f32x4 c4[2][2], b4[2][2];
#pragma unroll
        for (int bj = 0; bj < 2; ++bj)
#pragma unroll
            for (int n = 0; n < 2; ++n) { c4[bj][n] = *(const f32x4*)(cs + col0 + bj * HALF + 4 * n); b4[bj][n] = *(const f32x4*)(bw + col0 + bj * HALF + 4 * n); }
#pragma unroll
        for (int ai = 0; ai < 2; ++ai)
#pragma unroll
            for (int m = 0; m < 4; ++m) { const int r = row0 + ai * HALF + m * 16;
                const float mu = st[ai][m].x * INV_D, var = st[ai][m].y * INV_D - mu * mu, rstd = rsqrtf(var + LN_EPS);
                bf16_t* rowp = O + (size_t)r * ldc + col0;
#pragma unroll
                for (int bj = 0; bj < 2; ++bj) { const f32x4 v0 = (acc[ai][bj][m][0] - c4[bj][0] * mu) * rstd + b4[bj][0], v1 = (acc[ai][bj][m][1] - c4[bj][1] * mu) * rstd + b4[bj][1];
                    u32x4 w; w.x = cvt_pk_bf16(v0[0], v0[1]); w.y = cvt_pk_bf16(v0[2], v0[3]); w.z = cvt_pk_bf16(v1[0], v1[1]); w.w = cvt_pk_bf16(v1[2], v1[3]);
                    *(u32x4*)(rowp + bj * HALF) = w; } }
    }
};
struct EpiOut {
    static constexpr bool PERM = true, AFTER_DRAIN = false;
    const float* srcf; float* dstf; bf16_t* xb; const float* st_old; float* st_new; const float* g; const float* b; int wbf;
    template <bool SRCF>
    __device__ __forceinline__ void body(const f32x4 (&acc)[2][2][4][2], const Unit& u, int wr, int wc, int fr, int fq) const {
        const int row0 = u.pm * BM + wr * 64 + fr, col0 = u.pn * BM + wc * 32 + 8 * fq;
        f32x2 st[2]; st[0] = *(const f32x2*)(st_old + 2 * (size_t)row0);
        f32x4 g4[2][2], b4[2][2];
#pragma unroll
        for (int bj = 0; bj < 2; ++bj)
#pragma unroll
            for (int n = 0; n < 2; ++n) { g4[bj][n] = g ? *(const f32x4*)(g + col0 + bj * HALF + 4 * n) : (f32x4){1.f, 1.f, 1.f, 1.f}; b4[bj][n] = b ? *(const f32x4*)(b + col0 + bj * HALF + 4 * n) : (f32x4){0.f, 0.f, 0.f, 0.f}; }
        f32x4 po[SRCF ? 1 : 2][2][SRCF ? 2 : 1];
#pragma unroll
        for (int bj = 0; bj < 2; ++bj) { if (!SRCF) po[0][bj][0] = *(const f32x4*)(xb + (size_t)row0 * 1024 + col0 + bj * HALF); }
#pragma unroll
        for (int i = 0; i < 8; ++i) { const int ai = i >> 2, m = i & 3; const int r = row0 + ai * HALF + m * 16;
            if (i < 7) { const int rn = row0 + ((i + 1) >> 2) * HALF + ((i + 1) & 3) * 16; st[(i + 1) & 1] = *(const f32x2*)(st_old + 2 * (size_t)rn);
#pragma unroll
                for (int bj = 0; bj < 2; ++bj) { if (!SRCF) po[SRCF ? 0 : ((i + 1) & 1)][bj][0] = *(const f32x4*)(xb + (size_t)rn * 1024 + col0 + bj * HALF); } }
            if (SRCF) {
#pragma unroll
                for (int bj = 0; bj < 2; ++bj) { po[0][bj][0] = *(const f32x4*)(srcf + (size_t)r * 1024 + col0 + bj * HALF); po[0][bj][SRCF ? 1 : 0] = *(const f32x4*)(srcf + (size_t)r * 1024 + col0 + bj * HALF + 4); } }
            asm volatile("" ::: "memory");
            const float mu = st[i & 1].x * INV_D, var = st[i & 1].y * INV_D - mu * mu, rstd = rsqrtf(var + LN_EPS);
            const size_t off = (size_t)r * 1024 + col0; float s = 0.f, q = 0.f;
#pragma unroll
            for (int bj = 0; bj < 2; ++bj) { f32x4 v[2];
#pragma unroll
                for (int n = 0; n < 2; ++n) { f32x4 pv;
                    if (SRCF) pv = po[0][bj][SRCF ? n : 0];
                    else { const u32x4 raw = __builtin_bit_cast(u32x4, po[SRCF ? 0 : (i & 1)][bj][0]); const unsigned w0 = raw[2 * n], w1 = raw[2 * n + 1];
                           pv = (f32x4){__builtin_bit_cast(float, w0 << 16), __builtin_bit_cast(float, w0 & 0xffff0000u), __builtin_bit_cast(float, w1 << 16), __builtin_bit_cast(float, w1 & 0xffff0000u)}; }
                    const f32x4 x = (pv - mu) * rstd * g4[bj][n] + b4[bj][n]; v[n] = x * DN_ALPHA + acc[ai][bj][m][n];
                    s += (v[n][0] + v[n][1]) + (v[n][2] + v[n][3]); q += (v[n][0] * v[n][0] + v[n][1] * v[n][1]) + (v[n][2] * v[n][2] + v[n][3] * v[n][3]); }
                if (dstf) { *(f32x4*)(dstf + off + bj * HALF) = v[0]; *(f32x4*)(dstf + off + bj * HALF + 4) = v[1]; }
                if (wbf) { u32x4 w; w.x = cvt_pk_bf16(v[0][0], v[0][1]); w.y = cvt_pk_bf16(v[0][2], v[0][3]); w.z = cvt_pk_bf16(v[1][0], v[1][1]); w.w = cvt_pk_bf16(v[1][2], v[1][3]);
                       *(u32x4*)(xb + off + bj * HALF) = w; } }
            s += __shfl_xor(s, 16); s += __shfl_xor(s, 32); q += __shfl_xor(q, 16); q += __shfl_xor(q, 32);
            if (fq == 0) { unsafeAtomicAdd(st_new + 2 * (size_t)r, s); unsafeAtomicAdd(st_new + 2 * (size_t)r + 1, q); }
            asm volatile("" ::: "memory"); }
    }
    __device__ __forceinline__ void operator()(const f32x4 (&acc)[2][2][4][2], const Unit& u, int wr, int wc, int fr, int fq) const {
        if (srcf) body<true>(acc, u, wr, wc, fr, fq); else body<false>(acc, u, wr, wc, fr, fq);
    }
};
template <class Epi, class Sched, bool ALIGN_EPI = false, bool SP2 = false>
__device__ __forceinline__ void gemm_phase(PG8_LAS unsigned char* lds, const Gemm g, const Sched& S, const Epi& E, const int tid) {
    const int wid = __builtin_amdgcn_readfirstlane(tid >> 6), lane = tid & 63, wr = wid >> 2, wc = wid & 3, fr = lane & 15, fq = lane >> 4;
    const int K = g.K, nt = K / BK;
    unsigned voffA[2], voffB[2];
#pragma unroll
    for (int i = 0; i < 2; ++i) { int R, C; stage_rc(tid * 16 + i * 8192, R, C); const int Rb = Epi::PERM ? ((R & ~31) + perm32(R & 31)) : R;
        voffA[i] = (unsigned)(R * g.lda + C) * 2u; voffB[i] = (unsigned)(Rb * K + C) * 2u; }
    const size_t kstep = (size_t)(BK * 2);
    const size_t hstep = (size_t)HALF * K * 2;
    const size_t tstep = 2 * hstep; const size_t hstepA = (size_t)HALF * g.lda * 2; const size_t tstepA = 2 * hstepA;
    const unsigned ldsw = (unsigned)wid * 1024u;
    const int aoff = lds_byte(wr * 64 + fr, fq * 8), boff = lds_byte(wc * 32 + fr, fq * 8);
#define PG8_SA(b, h) (((b) * 2 + (h)) * HTB)
#define PG8_SB(b, h) ((4 + (b) * 2 + (h)) * HTB)
#define PG8_STAGE(bufoff, gbase, voff) do { _Pragma("unroll") for (int _i = 0; _i < 2; ++_i) \
        __builtin_amdgcn_global_load_lds((const unsigned*)((const char*)(gbase) + (voff)[_i]), (PG8_LAS unsigned*)(lds + (bufoff) + ldsw + _i * 8192), 16, 0, 0); } while (0)
#define PG8_LDA(dst, b, h) do { _Pragma("unroll") for (int m = 0; m < 4; ++m) _Pragma("unroll") for (int k = 0; k < 2; ++k) dst[m][k] = *(const PG8_LAS bf16x8*)(lds + PG8_SA(b, h) + aoff + m * 2048 + k * 1024); } while (0)
#define PG8_LDB(dst, b, h) do { _Pragma("unroll") for (int n = 0; n < 2; ++n) _Pragma("unroll") for (int k = 0; k < 2; ++k) dst[n][k] = *(const PG8_LAS bf16x8*)(lds + PG8_SB(b, h) + boff + n * 2048 + k * 1024); } while (0)
#define PG8_MMA(ai, bj, At, Bt) do { __builtin_amdgcn_s_setprio(1); _Pragma("unroll") for (int m = 0; m < 4; ++m) _Pragma("unroll") for (int n = 0; n < 2; ++n) _Pragma("unroll") for (int k = 0; k < 2; ++k) \
        acc[ai][bj][m][n] = __builtin_amdgcn_mfma_f32_16x16x32_bf16(Bt[n][k], At[m][k], acc[ai][bj][m][n], 0, 0, 0); __builtin_amdgcn_s_setprio(0); } while (0)
#define PG8_WAIT_V(n) asm volatile("s_waitcnt vmcnt(" #n ")" ::: "memory")
#define PG8_WAIT_L(n) asm volatile("s_waitcnt lgkmcnt(" #n ")" ::: "memory")
#define PG8_BAR __builtin_amdgcn_s_barrier()
#define PG8_SCHED __builtin_amdgcn_sched_barrier(0)
    Unit cur, nxt; int ui = 0;
    if (!S.next(0, cur)) return;
    f32x4 acc[2][2][4][2];
#pragma unroll
    for (int a = 0; a < 2; ++a)
#pragma unroll
        for (int b = 0; b < 2; ++b)
#pragma unroll
            for (int m = 0; m < 4; ++m)
#pragma unroll
                for (int n = 0; n < 2; ++n) acc[a][b][m][n] = (f32x4){0.f, 0.f, 0.f, 0.f};
    bf16x8 At[4][2], B0[2][2], B1[2][2];
    const char* cA = (const char*)g.A + (size_t)cur.pm * tstepA; const char* cB = (const char*)g.Bt + (size_t)cur.pn * tstep;
    S.a_ready(cur);
    if constexpr (SP2) {
        PG8_STAGE(PG8_SB(0, 0), cB, voffB); PG8_STAGE(PG8_SB(0, 1), cB + hstep, voffB); PG8_STAGE(PG8_SA(0, 0), cA, voffA); PG8_STAGE(PG8_SA(0, 1), cA + hstepA, voffA);
        if (wr == 1) PG8_BAR;
        PG8_WAIT_V(2); PG8_BAR;
        PG8_STAGE(PG8_SB(1, 0), cB + kstep, voffB); PG8_STAGE(PG8_SA(1, 0), cA + kstep, voffA); PG8_STAGE(PG8_SB(1, 1), cB + hstep + kstep, voffB);
        PG8_WAIT_V(6); PG8_BAR;
    } else {
        PG8_STAGE(PG8_SB(0, 0), cB, voffB); PG8_STAGE(PG8_SA(0, 0), cA, voffA); PG8_STAGE(PG8_SB(0, 1), cB + hstep, voffB); PG8_STAGE(PG8_SA(0, 1), cA + hstepA, voffA);
        if (wr == 1) PG8_BAR;
        PG8_WAIT_V(4); PG8_BAR;
        PG8_STAGE(PG8_SB(1, 0), cB + kstep, voffB); PG8_STAGE(PG8_SA(1, 0), cA + kstep, voffA); PG8_STAGE(PG8_SB(1, 1), cB + hstep + kstep, voffB);
        PG8_WAIT_V(6); PG8_BAR;
    }
    for (;;) {
        const bool has_next = S.next(ui + 1, nxt);
        const char* nA = has_next ? (const char*)g.A + (size_t)nxt.pm * tstepA : cA; const char* nB = has_next ? (const char*)g.Bt + (size_t)nxt.pn * tstep : cB;
        for (int t = 0; t < nt; t += 2) {
            const bool last = (t == nt - 2);
            const char* a1 = cA + (size_t)(t + 1) * kstep;
            const char* a2 = last ? nA : cA + (size_t)(t + 2) * kstep; const char* b2 = last ? nB : cB + (size_t)(t + 2) * kstep;
            const char* a3 = a2 + kstep; const char* b3 = b2 + kstep;
            if (last && has_next) S.a_ready(nxt);
            if constexpr (SP2) {
            PG8_LDB(B0, 0, 0); PG8_LDB(B1, 0, 1); PG8_SCHED; PG8_LDA(At, 0, 0); PG8_STAGE(PG8_SA(1, 1), a1 + hstepA, voffA);
            PG8_WAIT_V(8); PG8_WAIT_L(0); PG8_BAR; PG8_MMA(0, 0, At, B0); PG8_MMA(0, 1, At, B1); PG8_BAR; PG8_SCHED;
            PG8_LDA(At, 0, 1); PG8_STAGE(PG8_SB(0, 0), b2, voffB); PG8_STAGE(PG8_SB(0, 1), b2 + hstep, voffB); PG8_STAGE(PG8_SA(0, 0), a2, voffA);
            PG8_WAIT_V(8); PG8_WAIT_L(0); PG8_BAR; PG8_MMA(1, 0, At, B0); PG8_MMA(1, 1, At, B1); PG8_BAR; PG8_SCHED;
            PG8_LDB(B0, 1, 0); PG8_LDB(B1, 1, 1); PG8_SCHED; PG8_LDA(At, 1, 0); PG8_STAGE(PG8_SA(0, 1), a2 + hstepA, voffA);
            PG8_WAIT_V(8); PG8_WAIT_L(0); PG8_BAR; PG8_MMA(0, 0, At, B0); PG8_MMA(0, 1, At, B1); PG8_BAR; PG8_SCHED;
            PG8_LDA(At, 1, 1); PG8_STAGE(PG8_SB(1, 0), b3, voffB); PG8_STAGE(PG8_SB(1, 1), b3 + hstep, voffB); PG8_STAGE(PG8_SA(1, 0), a3, voffA);
            PG8_WAIT_V(8); PG8_WAIT_L(0); PG8_BAR; PG8_MMA(1, 0, At, B0); PG8_MMA(1, 1, At, B1); PG8_BAR; PG8_SCHED;
            } else {
            PG8_LDB(B0, 0, 0); PG8_SCHED; PG8_LDA(At, 0, 0); PG8_STAGE(PG8_SA(1, 1), a1 + hstepA, voffA);
            PG8_WAIT_L(8); PG8_BAR; PG8_WAIT_L(0); PG8_MMA(0, 0, At, B0); PG8_BAR; PG8_SCHED;
            PG8_LDB(B1, 0, 1); PG8_STAGE(PG8_SB(0, 0), b2, voffB);
            PG8_BAR; PG8_WAIT_L(0); PG8_MMA(0, 1, At, B1); PG8_BAR;
            PG8_LDA(At, 0, 1); PG8_STAGE(PG8_SA(0, 0), a2, voffA);
            PG8_BAR; PG8_WAIT_L(0); PG8_MMA(1, 0, At, B0); PG8_BAR; PG8_SCHED;
            PG8_STAGE(PG8_SB(0, 1), b2 + hstep, voffB);
            PG8_WAIT_V(6); PG8_BAR; PG8_MMA(1, 1, At, B1); PG8_BAR;
            PG8_LDB(B0, 1, 0); PG8_SCHED; PG8_LDA(At, 1, 0); PG8_STAGE(PG8_SA(0, 1), a2 + hstepA, voffA);
            PG8_WAIT_L(8); PG8_BAR; PG8_WAIT_L(0); PG8_MMA(0, 0, At, B0); PG8_BAR; PG8_SCHED;
            PG8_LDB(B1, 1, 1); PG8_STAGE(PG8_SB(1, 0), b3, voffB);
            PG8_BAR; PG8_WAIT_L(0); PG8_MMA(0, 1, At, B1); PG8_BAR;
            PG8_LDA(At, 1, 1); PG8_STAGE(PG8_SA(1, 0), a3, voffA);
            PG8_BAR; PG8_WAIT_L(0); PG8_MMA(1, 0, At, B0); PG8_BAR; PG8_SCHED;
            PG8_STAGE(PG8_SB(1, 1), b3 + hstep, voffB);
            PG8_WAIT_V(6); PG8_BAR; PG8_MMA(1, 1, At, B1); PG8_BAR;
            }
        }
        if constexpr (ALIGN_EPI) { if (wr == 0) PG8_BAR; }
        if constexpr (!Epi::AFTER_DRAIN) { E(acc, cur, wr, wc, fr, fq); S.done(cur); }
        if (!has_next) break;
#pragma unroll
        for (int a = 0; a < 2; ++a)
#pragma unroll
            for (int b = 0; b < 2; ++b)
#pragma unroll
                for (int m = 0; m < 4; ++m)
#pragma unroll
                    for (int n = 0; n < 2; ++n) acc[a][b][m][n] = (f32x4){0.f, 0.f, 0.f, 0.f};
        cur = nxt; cA = nA; cB = nB; ++ui;
        if constexpr (ALIGN_EPI) { if (wr == 1) PG8_BAR; }
    }
    PG8_WAIT_V(0);
    if constexpr (!ALIGN_EPI) { if (wr == 0) PG8_BAR; }
    PG8_BAR;
    if constexpr (Epi::AFTER_DRAIN) { E.fused(acc, cur, wr, wc, fr, fq, lds, wid, lane); S.done(cur); }
#undef PG8_SA
#undef PG8_SB
#undef PG8_STAGE
#undef PG8_LDA
#undef PG8_LDB
#undef PG8_MMA
#undef PG8_WAIT_V
#undef PG8_WAIT_L
#undef PG8_BAR
#undef PG8_SCHED
}
}
#define LAS __attribute__((address_space(3)))
typedef unsigned short bf16_t;
typedef short bf16x8 __attribute__((ext_vector_type(8)));
typedef float f32x4 __attribute__((ext_vector_type(4)));
typedef float f32x2 __attribute__((ext_vector_type(2)));
typedef float f32x16 __attribute__((ext_vector_type(16)));
typedef unsigned u32x4 __attribute__((ext_vector_type(4)));
typedef unsigned u32x2 __attribute__((ext_vector_type(2)));

constexpr int D = 1024, BATCH = 4, SEQ = 8192, M = BATCH * SEQ, DEPTH = 4, NCHUNK = SEQ / 64;
constexpr int HP = 5120;
constexpr int QOFF = 0, QMOFF = 1024, KOFF = 1536, VOFF = 2560, ZOFF = 3584;
constexpr int EB = 1536;
constexpr int NWAVES = 8;
constexpr float LOG2E = 1.4426950408889634f;
constexpr float LN_EPS = 1e-5f, INV_D = 1.0f / 1024.0f;
constexpr size_t MiB = 1u << 20;
constexpr size_t WS_CS = 0, WS_BW = 128 * 1024, WS_STATS = 256 * 1024, CTL_BYTES = 2 * MiB;
constexpr size_t WS_WIN = 2 * MiB, WS_WOUT = 42 * MiB, WS_WKV = 54 * MiB, WS_MEMB = 62 * MiB, WS_KVMEM = 64 * MiB, WS_XB = 72 * MiB, WS_H = 136 * MiB, WS_END = 456 * MiB;
static_assert(WS_STATS + (size_t)5 * M * 8 <= CTL_BYTES, "ctl");
constexpr int LDS_BYTES = 160000;
constexpr int LDS_BAR = 159744;
constexpr size_t WS_QCTR = 1700 * 1024;
constexpr size_t WS_BAR = 1536 * 1024;
constexpr int WAVE_LDS = 19488;
constexpr int VPITCH = 144;

__device__ __forceinline__ unsigned f2bf(float f) { unsigned u = __builtin_bit_cast(unsigned, f); return (u + 0x7fffu + ((u >> 16) & 1u)) >> 16; }
__device__ __forceinline__ unsigned pk2(float lo, float hi) { return f2bf(lo) | (f2bf(hi) << 16); }
__device__ __forceinline__ float bfr(float f) { return __builtin_bit_cast(float, f2bf(f) << 16); }
__device__ __forceinline__ float bflo(unsigned w) { return __builtin_bit_cast(float, w << 16); }
__device__ __forceinline__ float bfhi(unsigned w) { return __builtin_bit_cast(float, w & 0xffff0000u); }
__device__ __forceinline__ float silu(float z) { return z * __builtin_amdgcn_rcpf(1.0f + __builtin_amdgcn_exp2f(-z * LOG2E)); }
#define LDS_WAIT() asm volatile("s_waitcnt lgkmcnt(0)" ::: "memory")
__device__ __forceinline__ int lane_now() { int l; asm volatile("v_mbcnt_lo_u32_b32 %0, -1, 0\n\tv_mbcnt_hi_u32_b32 %0, -1, %0" : "=v"(l)); return l; }

struct TItem { const float* W; bf16_t* WT; const float* gv; const float* bv; float* cs; float* bw; int K, N, drow, k0, n0, scale; };
__device__ __forceinline__ void ti_load(const TItem& t, int lane, float (&w)[32]) {
#pragma unroll
    for (int i = 0; i < 32; ++i) { const int kk = 2 * i + (lane >> 5); w[i] = t.W[(size_t)(t.k0 + kk) * t.N + t.n0 + (lane & 31)]; }
}
__device__ __forceinline__ void ti_process(const TItem& t, LAS float* scr, int lane, const float (&wv)[32]) {
    float csp = 0.f, bwp = 0.f;
    if (t.scale) {
#pragma unroll
        for (int i = 0; i < 32; ++i) { const int kk = 2 * i + (lane >> 5); float w = wv[i]; const float gk = t.gv ? t.gv[t.k0 + kk] : 1.f, bk = t.bv ? t.bv[t.k0 + kk] : 0.f; bwp += w * bk; w *= gk; csp += bfr(w); scr[kk * 33 + (lane & 31)] = w; }
    } else {
#pragma unroll
        for (int i = 0; i < 32; ++i) { const int kk = 2 * i + (lane >> 5); scr[kk * 33 + (lane & 31)] = wv[i]; }
    }
    LDS_WAIT();
    const int c = lane & 7;
#pragma unroll
    for (int j = 0; j < 4; ++j) { const int n = (lane >> 3) + 8 * j; const LAS float* s = scr + (8 * c) * 33 + n;
        u32x4 o; o.x = pk2(s[0 * 33], s[1 * 33]); o.y = pk2(s[2 * 33], s[3 * 33]); o.z = pk2(s[4 * 33], s[5 * 33]); o.w = pk2(s[6 * 33], s[7 * 33]);
        *(u32x4*)(t.WT + (size_t)(t.drow + n) * t.K + t.k0 + 8 * c) = o; }
    LDS_WAIT();
    if (t.scale) { csp += __shfl_xor(csp, 32); bwp += __shfl_xor(bwp, 32);
        if (lane < 32) { unsafeAtomicAdd(t.cs + t.drow + lane, csp); unsafeAtomicAdd(t.bw + t.drow + lane, bwp); } }
}
__device__ __forceinline__ void row_to_bf16(const float* xrow, bf16_t* orow, int lane) {
    const f32x4* xr = (const f32x4*)xrow + lane; u32x2* o8 = (u32x2*)orow + lane;
#pragma unroll
    for (int j = 0; j < 4; ++j) { const f32x4 v = xr[64 * j]; u32x2 w; w.x = pk2(v[0], v[1]); w.y = pk2(v[2], v[3]); o8[64 * j] = w; }
}

struct Args { const float *x, *mem, *w_in, *w_kv, *w_out, *rel, *convw, *lng, *lnb; float* out; unsigned char* ws; int ph_lo, ph_hi; };

__device__ __forceinline__ void prologue(const Args& a, unsigned char* ws, LAS unsigned char* lds, int gw, int NGW, int wave, int lane) {
    LAS float* scr = (LAS float*)(lds + wave * WAVE_LDS);
    constexpr int I_IN = 16 * 160, I_OUT = 24 * 32, I_KV = 16 * 32;
    constexpr int NITEMS = DEPTH * (I_IN + I_OUT + I_KV);
    auto decode = [&](int it, TItem& t) {
        int r = it;
        if (r < DEPTH * I_IN) { const int l = r / I_IN, q = r % I_IN, kb = q / 160, nb = q % 160, n0 = nb * 32;
            const int dn = n0 < 1024 ? n0 : (n0 < 3072 ? n0 + 512 : (n0 < 3584 ? n0 - 2048 : n0));
            t.W = a.w_in + (size_t)l * D * HP; t.K = D; t.N = HP; t.WT = (bf16_t*)(ws + WS_WIN) + (size_t)l * HP * D; t.drow = dn; t.k0 = kb * 64; t.n0 = n0;
            t.gv = l ? a.lng + (l - 1) * D : nullptr; t.bv = l ? a.lnb + (l - 1) * D : nullptr; t.cs = (float*)(ws + WS_CS) + l * HP; t.bw = (float*)(ws + WS_BW) + l * HP; t.scale = 1; return; }
        r -= DEPTH * I_IN; t.gv = nullptr; t.bv = nullptr; t.cs = nullptr; t.bw = nullptr; t.scale = 0;
        if (r < DEPTH * I_OUT) { const int l = r / I_OUT, q = r % I_OUT, kb = q / 32, nb = q % 32;
            t.W = a.w_out + (size_t)l * EB * D; t.K = EB; t.N = D; t.WT = (bf16_t*)(ws + WS_WOUT) + (size_t)l * D * EB; t.drow = nb * 32; t.k0 = kb * 64; t.n0 = nb * 32; return; }
        r -= DEPTH * I_OUT;
        { const int l = r / I_KV, q = r % I_KV, kb = q / 32, nb = q % 32;
            t.W = a.w_kv + (size_t)l * D * D; t.K = D; t.N = D; t.WT = (bf16_t*)(ws + WS_WKV) + (size_t)l * D * D; t.drow = nb * 32; t.k0 = kb * 64; t.n0 = nb * 32; }
    };
    if (gw < NITEMS) {
        TItem cur; decode(gw, cur); float wc[32]; ti_load(cur, lane, wc);
        for (int it = gw; it < NITEMS; it += NGW) {
            TItem nxt = cur; float wn[32]; const bool more = it + NGW < NITEMS;
            if (more) { decode(it + NGW, nxt); ti_load(nxt, lane, wn); }
            ti_process(cur, scr, lane, wc);
            if (more) { cur = nxt;
#pragma unroll
                for (int i = 0; i < 32; ++i) wc[i] = wn[i]; }
        }
    }
    lane = lane_now();
    float* st0 = (float*)(ws + WS_STATS);
    for (int m = gw; m < M; m += 4 * NGW) {
        f32x4 v[4][4];
#pragma unroll
        for (int r = 0; r < 4; ++r)
#pragma unroll
            for (int j = 0; j < 4; ++j) v[r][j] = ((const f32x4*)(a.x + (size_t)(m + r * NGW) * D))[64 * j + lane];
#pragma unroll
        for (int r = 0; r < 4; ++r) { u32x2* o8 = (u32x2*)((bf16_t*)(ws + WS_XB) + (size_t)(m + r * NGW) * D) + lane;
#pragma unroll
            for (int j = 0; j < 4; ++j) { u32x2 w; w.x = pk2(v[r][j][0], v[r][j][1]); w.y = pk2(v[r][j][2], v[r][j][3]); o8[64 * j] = w; }
            if (lane == 0) { float c0 = 0.f, c1 = 1024.0f * (1.0f - LN_EPS); asm volatile("" : "+v"(c0), "+v"(c1));
                st0[2 * (size_t)(m + r * NGW)] = c0; st0[2 * (size_t)(m + r * NGW) + 1] = c1; } }
    }
    for (int m = gw; m < BATCH * 256; m += NGW) row_to_bf16(a.mem + (size_t)m * D, (bf16_t*)(ws + WS_MEMB) + (size_t)m * D, lane);
}

typedef short s16x4 __attribute__((ext_vector_type(4)));
typedef __bf16 bf2_t __attribute__((ext_vector_type(2)));
__device__ __forceinline__ unsigned cvtpk(float lo, float hi) { const f32x2 v = {lo, hi}; return __builtin_bit_cast(unsigned, __builtin_convertvector(v, bf2_t)); }
template <int DH, int KEYS, int NQ, bool BIAS, bool STAGE = true>
__device__ __forceinline__ void attn_task(const bf16_t* qbase, const bf16_t* kbase, const bf16_t* vbase, const bf16_t* zbase, bf16_t* ybase,
                                          int ldq, int ldkv, int ntiles, int jrot, int rel00, float scale, LAS unsigned char* kbuf, LAS unsigned char* vbuf, const LAS float* tab, int lane) {
    const int n = lane & 31, hh = lane >> 5;
    constexpr int KS = DH / 16, DB = DH / 32, PITCH = DH * 2 + 16, CPR = DH / 8  , RPI = 64 / CPR  , NP = KEYS / RPI;
    static_assert(KEYS == 32, "one 32-key row block per tile");
    const unsigned g0 = (unsigned)((lane / CPR) * ldkv + (lane % CPR) * 8), l0 = (unsigned)((lane / CPR) * PITCH + (lane % CPR) * 16);
    u32x4 kr[STAGE ? NP : 1], vr[STAGE ? NP : 1];
    if constexpr (STAGE) { const bf16_t* kt = kbase + (size_t)jrot * KEYS * ldkv; const bf16_t* vt = vbase + (size_t)jrot * KEYS * ldkv;
#pragma unroll
    for (int it = 0; it < NP; ++it) { kr[it] = *(const u32x4*)(kt + (size_t)it * RPI * ldkv + g0); vr[it] = *(const u32x4*)(vt + (size_t)it * RPI * ldkv + g0); } }
    bf16x8 qf[NQ][KS];
#pragma unroll
    for (int cq = 0; cq < NQ; ++cq)
#pragma unroll
        for (int ks = 0; ks < KS; ++ks) qf[cq][ks] = *(const bf16x8*)(qbase + (size_t)(32 * cq + n) * ldq + ks * 16 + hh * 8);
    f32x16 O[NQ][DB];
#pragma unroll
    for (int cq = 0; cq < NQ; ++cq)
#pragma unroll
        for (int d = 0; d < DB; ++d)
#pragma unroll
            for (int i = 0; i < 16; ++i) O[cq][d][i] = 0.f;
    float mrun[NQ], lsum[NQ];
#pragma unroll
    for (int cq = 0; cq < NQ; ++cq) { mrun[cq] = -1e30f; lsum[cq] = 0.f; }
    if constexpr (STAGE) { LDS_WAIT();
#pragma unroll
    for (int it = 0; it < NP; ++it) { *(LAS u32x4*)(kbuf + l0 + it * RPI * PITCH) = kr[it]; *(LAS u32x4*)(vbuf + l0 + it * RPI * PITCH) = vr[it]; } }
    const LAS unsigned char* kl0 = kbuf + n * PITCH + hh * 16;
    const LAS unsigned char* vl0 = vbuf + (4 * hh + ((lane & 15) >> 2)) * PITCH + (16 * ((lane >> 4) & 1) + 4 * (lane & 3)) * 2;
    __builtin_amdgcn_s_waitcnt(0x0F70);
    int j = jrot;
    for (int st = 0; st < ntiles; ++st) {
        const bool more = st + 1 < ntiles; const int jn = (j + 1 == ntiles) ? 0 : j + 1;
        const LAS unsigned char* kl = STAGE ? kl0 : kl0 + j * KEYS * PITCH; const LAS unsigned char* vl = STAGE ? vl0 : vl0 + j * KEYS * PITCH;
        if (STAGE && more) { const bf16_t* kt = kbase + (size_t)jn * KEYS * ldkv; const bf16_t* vt = vbase + (size_t)jn * KEYS * ldkv;
#pragma unroll
            for (int it = 0; it < NP; ++it) { kr[it] = *(const u32x4*)(kt + (size_t)it * RPI * ldkv + g0); vr[it] = *(const u32x4*)(vt + (size_t)it * RPI * ldkv + g0); } }
        bf16x8 kf[KS];
#pragma unroll
        for (int ks = 0; ks < KS; ++ks) kf[ks] = *(const LAS bf16x8*)(kl + ks * 32);
        union { bf16x8 v; s16x4 h[2]; } vf[2][DB];
        constexpr bool EARLY_V = (DH == 64);
#define ATT_LOAD_VF() _Pragma("unroll") for (int s = 0; s < 2; ++s) _Pragma("unroll") for (int d = 0; d < DB; ++d) { \
                vf[s][d].h[0] = __builtin_amdgcn_ds_read_tr16_b64_v4i16((LAS s16x4*)(vl + (16 * s) * PITCH + d * 64)); \
                vf[s][d].h[1] = __builtin_amdgcn_ds_read_tr16_b64_v4i16((LAS s16x4*)(vl + (16 * s + 8) * PITCH + d * 64)); }
        if (EARLY_V) { ATT_LOAD_VF() }
        const int rel0 = rel00 - j * KEYS;
        const bool elementwise = BIAS && rel0 < 160; const float bc = (BIAS && !elementwise) ? tab[0] : 0.f;
        f32x16 SS[NQ];
#pragma unroll
        for (int cq = 0; cq < NQ; ++cq)
#pragma unroll
            for (int i = 0; i < 16; ++i) SS[cq][i] = 0.f;
#pragma unroll
        for (int ks = 0; ks < KS; ++ks)
#pragma unroll
            for (int cq = 0; cq < NQ; ++cq) SS[cq] = __builtin_amdgcn_mfma_f32_32x32x16_bf16(kf[ks], qf[cq][ks], SS[cq], 0, 0, 0);
#pragma unroll
        for (int cq = 0; cq < NQ; ++cq) {
            f32x16 S = SS[cq];
            if (BIAS && elementwise) { const LAS float* tp = tab + (191 - rel0 - 32 * cq - n + 4 * hh);
#pragma unroll
                for (int i = 0; i < 16; ++i) S[i] = S[i] * scale + tp[(i & 3) + 8 * (i >> 2)]; }
            float mx = S[0];
#pragma unroll
            for (int i = 1; i < 16; ++i) mx = fmaxf(mx, S[i]);
            mx = fmaxf(mx, __shfl_xor(mx, 32));
            if (!elementwise) mx = mx * scale + bc;
            const bool grew = mx > mrun[cq] + 8.0f; const float mnew = grew ? mx : mrun[cq], alpha = __builtin_amdgcn_exp2f(mrun[cq] - mnew);
            mrun[cq] = mnew;
            float ps = 0.f;
            if (elementwise) {
#pragma unroll
                for (int i = 0; i < 16; ++i) { S[i] = __builtin_amdgcn_exp2f(S[i] - mnew); ps += S[i]; }
            } else { const float cc = bc - mnew;
#pragma unroll
                for (int i = 0; i < 16; ++i) { S[i] = __builtin_amdgcn_exp2f(S[i] * scale + cc); ps += S[i]; }
            }
            lsum[cq] = lsum[cq] * alpha + ps;
            if (__builtin_amdgcn_ballot_w64(grew) != 0ull) {
#pragma unroll
                for (int d = 0; d < DB; ++d)
#pragma unroll
                    for (int i = 0; i < 16; ++i) O[cq][d][i] *= alpha;
            }
            union { bf16x8 v; unsigned u[4]; } pf[2];
#pragma unroll
            for (int e = 0; e < 4; ++e) { pf[0].u[e] = cvtpk(S[2 * e], S[2 * e + 1]); pf[1].u[e] = cvtpk(S[8 + 2 * e], S[9 + 2 * e]); }
            if (!EARLY_V) { ATT_LOAD_VF() }
#pragma unroll
            for (int s = 0; s < 2; ++s)
#pragma unroll
                for (int d = 0; d < DB; ++d) O[cq][d] = __builtin_amdgcn_mfma_f32_32x32x16_bf16(vf[s][d].v, pf[s].v, O[cq][d], 0, 0, 0);
        }
        if (STAGE && more) {
            LDS_WAIT();
#pragma unroll
            for (int it = 0; it < NP; ++it) { *(LAS u32x4*)(kbuf + l0 + it * RPI * PITCH) = kr[it]; *(LAS u32x4*)(vbuf + l0 + it * RPI * PITCH) = vr[it]; }
        }
        j = jn;
    }
    float inv[NQ];
#pragma unroll
    for (int cq = 0; cq < NQ; ++cq) inv[cq] = 1.0f / (lsum[cq] + __shfl_xor(lsum[cq], 32));
    if constexpr (STAGE) {
        constexpr int OP = DH * 4 + 16, ROWS = 32 * NQ, NIT = ROWS * DH / 8 / 64, CPRO = DH / 8;
        static_assert(ROWS * OP <= 18432, "O tile fits the wave's K+V buffers");
        u32x4 zz[NIT];
#pragma unroll
        for (int it = 0; it < NIT; ++it) { const int id = it * 64 + lane, row = id / CPRO, chn = id % CPRO; zz[it] = *(const u32x4*)(zbase + (size_t)row * ldq + chn * 8); }
        LDS_WAIT();
#pragma unroll
        for (int cq = 0; cq < NQ; ++cq)
#pragma unroll
            for (int d = 0; d < DB; ++d)
#pragma unroll
                for (int g4 = 0; g4 < 4; ++g4) { const f32x4 v = {O[cq][d][4 * g4] * inv[cq], O[cq][d][4 * g4 + 1] * inv[cq], O[cq][d][4 * g4 + 2] * inv[cq], O[cq][d][4 * g4 + 3] * inv[cq]};
                    *(LAS f32x4*)(kbuf + (32 * cq + n) * OP + (32 * d + 8 * g4 + 4 * hh) * 4) = v; }
        LDS_WAIT();
        {
#pragma unroll
        for (int it = 0; it < NIT; ++it) { const int id = it * 64 + lane, row = id / CPRO, chn = id % CPRO;
            const f32x4 o0 = *(const LAS f32x4*)(kbuf + row * OP + chn * 32), o1 = *(const LAS f32x4*)(kbuf + row * OP + chn * 32 + 16); const u32x4 z = zz[it];
            u32x4 w; w.x = cvtpk(o0[0] * silu(bflo(z.x)), o0[1] * silu(bfhi(z.x))); w.y = cvtpk(o0[2] * silu(bflo(z.y)), o0[3] * silu(bfhi(z.y)));
                     w.z = cvtpk(o1[0] * silu(bflo(z.z)), o1[1] * silu(bfhi(z.z))); w.w = cvtpk(o1[2] * silu(bflo(z.w)), o1[3] * silu(bfhi(z.w)));
            *(u32x4*)(ybase + (size_t)row * ldq + chn * 8) = w; } }
        LDS_WAIT();
    } else {
        static_assert(NQ == 1 && !BIAS, "non-staged form: one query block, no bias table"); LAS unsigned char* otb = (LAS unsigned char*)tab;
        u32x4 zq[DB][2];
#pragma unroll
        for (int d = 0; d < DB; ++d)
#pragma unroll
            for (int i2 = 0; i2 < 2; ++i2) { const int row = i2 * 16 + (lane >> 2), chn = lane & 3; zq[d][i2] = *(const u32x4*)(zbase + (size_t)row * ldq + 32 * d + chn * 8); }
#pragma unroll
        for (int d = 0; d < DB; ++d) {
            LDS_WAIT();
#pragma unroll
            for (int g4 = 0; g4 < 4; ++g4) { u32x2 w; w.x = cvtpk(O[0][d][4 * g4] * inv[0], O[0][d][4 * g4 + 1] * inv[0]); w.y = cvtpk(O[0][d][4 * g4 + 2] * inv[0], O[0][d][4 * g4 + 3] * inv[0]);
                *(LAS u32x2*)(otb + n * 80 + (8 * g4 + 4 * hh) * 2) = w; }
            LDS_WAIT();
#pragma unroll
            for (int i2 = 0; i2 < 2; ++i2) { const int row = i2 * 16 + (lane >> 2), chn = lane & 3; const u32x4 o = *(const LAS u32x4*)(otb + row * 80 + chn * 16); const u32x4 z = zq[d][i2];
                u32x4 w; w.x = cvtpk(bflo(o.x) * silu(bflo(z.x)), bfhi(o.x) * silu(bfhi(z.x))); w.y = cvtpk(bflo(o.y) * silu(bflo(z.y)), bfhi(o.y) * silu(bfhi(z.y)));
                         w.z = cvtpk(bflo(o.z) * silu(bflo(z.z)), bfhi(o.z) * silu(bfhi(z.z))); w.w = cvtpk(bflo(o.w) * silu(bflo(z.w)), bfhi(o.w) * silu(bfhi(z.w)));
                *(u32x4*)(ybase + (size_t)row * ldq + 32 * d + chn * 8) = w; }
        }
        LDS_WAIT();
    }
}

__device__ __forceinline__ void conv_task(bf16_t* h, const float* cw, int b, int c, int part, int lane) {
    const int th = part >> 1, ch = (part & 1) * 512 + lane * 8, t0 = c * 64 + th * 32;
    float w0[8], w1[8], w2[8], um2[8], um1[8];
#pragma unroll
    for (int e = 0; e < 8; ++e) { w0[e] = cw[ch + e]; w1[e] = cw[D + ch + e]; w2[e] = cw[2 * D + ch + e]; um2[e] = 0.f; um1[e] = 0.f; }
    bf16_t* row0 = h + (size_t)(b * SEQ + t0) * HP;
    if (t0 >= 2) {
        const u32x4 a2 = *(const u32x4*)(row0 - 2 * (size_t)HP + KOFF + ch), b2 = *(const u32x4*)(row0 - 2 * (size_t)HP + VOFF + ch);
        const u32x4 a1 = *(const u32x4*)(row0 - (size_t)HP + KOFF + ch), b1 = *(const u32x4*)(row0 - (size_t)HP + VOFF + ch);
#pragma unroll
        for (int e = 0; e < 4; ++e) { um2[2 * e] = bflo(a2[e]) * bflo(b2[e]); um2[2 * e + 1] = bfhi(a2[e]) * bfhi(b2[e]); um1[2 * e] = bflo(a1[e]) * bflo(b1[e]); um1[2 * e + 1] = bfhi(a1[e]) * bfhi(b1[e]); }
    }
    u32x4 na[4], nb[4], np[4], nz[4];
#pragma unroll
    for (int r = 0; r < 4; ++r) { bf16_t* row = row0 + (size_t)r * HP; na[r] = *(const u32x4*)(row + KOFF + ch); nb[r] = *(const u32x4*)(row + VOFF + ch); np[r] = *(const u32x4*)(row + QOFF + ch); nz[r] = *(const u32x4*)(row + ZOFF + ch); }
    for (int tb = 0; tb < 32; tb += 4) {
        u32x4 pa[4], pb[4], pp[4], pz[4];
#pragma unroll
        for (int r = 0; r < 4; ++r) { pa[r] = na[r]; pb[r] = nb[r]; pp[r] = np[r]; pz[r] = nz[r]; }
        if (tb + 4 < 32) {
#pragma unroll
            for (int r = 0; r < 4; ++r) { bf16_t* row = row0 + (size_t)(tb + 4 + r) * HP; na[r] = *(const u32x4*)(row + KOFF + ch); nb[r] = *(const u32x4*)(row + VOFF + ch); np[r] = *(const u32x4*)(row + QOFF + ch); nz[r] = *(const u32x4*)(row + ZOFF + ch); } }
#pragma unroll
        for (int r = 0; r < 4; ++r) { float u[8]; u32x4 o;
#pragma unroll
            for (int e = 0; e < 4; ++e) { u[2 * e] = bflo(pa[r][e]) * bflo(pb[r][e]); u[2 * e + 1] = bfhi(pa[r][e]) * bfhi(pb[r][e]); }
#pragma unroll
            for (int e = 0; e < 4; ++e) { const float c0 = w0[2 * e] * um2[2 * e] + w1[2 * e] * um1[2 * e] + w2[2 * e] * u[2 * e], c1 = w0[2 * e + 1] * um2[2 * e + 1] + w1[2 * e + 1] * um1[2 * e + 1] + w2[2 * e + 1] * u[2 * e + 1];
                o[e] = pk2(bflo(pp[r][e]) * c0 * silu(bflo(pz[r][e])), bfhi(pp[r][e]) * c1 * silu(bfhi(pz[r][e]))); }
            *(u32x4*)(row0 + (size_t)(tb + r) * HP + QOFF + ch) = o;
#pragma unroll
            for (int e = 0; e < 8; ++e) { um2[e] = um1[e]; um1[e] = u[e]; } }
    }
}

__device__ __forceinline__ void mixer_phase(const Args& a, unsigned char* ws, int layer, LAS unsigned char* lds, int gw, int NGW, int wave, int lane) {
    LAS unsigned char* kbuf = lds + wave * WAVE_LDS; LAS unsigned char* vbuf = kbuf + 9216; LAS float* tab = (LAS float*)(kbuf + 18432);
    bf16_t* h = (bf16_t*)(ws + WS_H); const bf16_t* kvm = (const bf16_t*)(ws + WS_KVMEM);
    const bool is_attn = (layer & 1) == 0;
    const int LW = NGW / 8, x = gw / LW;
    const int b = x >> 1, cbeg = (x & 1) * 64;
    unsigned* ctr = (unsigned*)(ws + WS_QCTR) + (layer * 8 + x) * 64;
    const int n_mix = is_attn ? 1024 : 256, ntask = n_mix;
    {
        const int wgx = (gw % LW) >> 3, mh = wgx & 3, grp = wgx >> 2, tid = wave * 64 + lane;
        LAS unsigned char* Kl = lds; LAS unsigned char* Vl = lds + 256 * 272;
        const bf16_t* kb = kvm + (size_t)b * 256 * 4096 + layer * 1024 + mh * 128;
        for (int kv = 0; kv < 2; ++kv) { u32x4 tk[8];
#pragma unroll
            for (int i = 0; i < 8; ++i) { const int id = tid + 512 * i, row = id >> 4, chn = id & 15; tk[i] = *(const u32x4*)(kb + kv * 512 + (size_t)row * 4096 + chn * 8); }
#pragma unroll
            for (int i = 0; i < 8; ++i) { const int id = tid + 512 * i, row = id >> 4, chn = id & 15; *(LAS u32x4*)((kv ? Vl : Kl) + row * 272 + chn * 16) = tk[i]; } }
        __syncthreads();
        for (int i = 0; i < 2; ++i) { int lane; asm volatile("v_mbcnt_lo_u32_b32 %0, -1, 0\n\tv_mbcnt_hi_u32_b32 %0, -1, %0" : "=v"(lane)); const int qbi = grp * 16 + wave * 2 + i, c = cbeg + (qbi >> 1), qh = qbi & 1; const size_t R0 = (size_t)b * SEQ + c * 64 + qh * 32;
            bf16_t* qb = h + R0 * HP + QMOFF + mh * 128;
            attn_task<128, 32, 1, false, false>(qb, nullptr, nullptr, h + R0 * HP + ZOFF + 1024 + mh * 128, qb, HP, 4096, 8, 0, 0, 0.08838834764831845f * LOG2E, Kl, Vl, (const LAS float*)(lds + 139264 + wave * 2560), lane); }
        __syncthreads();
    }
    for (;;) {
        int lane; asm volatile("v_mbcnt_lo_u32_b32 %0, -1, 0\n\tv_mbcnt_hi_u32_b32 %0, -1, %0" : "=v"(lane));
        unsigned tq = 0; if (lane == 0) tq = __hip_atomic_fetch_add(ctr, 1u, __ATOMIC_RELAXED, __HIP_MEMORY_SCOPE_AGENT);
        const int t = __builtin_amdgcn_readfirstlane((int)tq);
        if (t >= ntask) break;
        if (is_attn) {
            const int head = t & 15, c = cbeg + 63 - (t >> 4), jlo = c < 8 ? 0 : c - 8; const size_t R0 = (size_t)b * SEQ + c * 64;
            const float* rb = a.rel + ((size_t)(layer >> 1) * 16 + head) * 257;
            LDS_WAIT();
#pragma unroll
            for (int k = 0; k < 4; ++k) { const int xx = lane + 64 * k, rel = 191 - xx; tab[xx] = rb[(rel > 128 ? 128 : rel) + 128] * LOG2E; }
            LDS_WAIT();
            bf16_t* qb = h + R0 * HP + QOFF + head * 64; const bf16_t* kb = h + ((size_t)b * SEQ + jlo * 64) * HP + KOFF + head * 64;
            attn_task<64, 32, 2, true>(qb, kb, kb + (VOFF - KOFF), h + R0 * HP + ZOFF + head * 64, qb, HP, HP, 2 * (c - jlo + 1), c >= 8 ? (18 - (2 * (c - 8)) % 18) % 18 : 0, 64 * (c - jlo), 0.125f * LOG2E, kbuf, vbuf, tab, lane);
        } else {
            conv_task(h, a.convw + (size_t)(layer >> 1) * 3 * D, b, cbeg + (t >> 2), t & 3, lane);
        }
    }
}

#define XB_TMO      128
#define XB_XCNT(j)  (256  + 64 * (j))
#define XB_XSUB(j)  (1280 + 64 * (j))
#define XB_XGEN(j)  (2304 + 64 * (j))
#define XB_TOP      3328
#define XB_TOPGEN   3392
#define XCD_BAR_WORDS 3456
#define XB_SPIN_CAP (1u << 18)

__device__ __forceinline__ unsigned xb_ld(unsigned* p)              { return __hip_atomic_load(p, __ATOMIC_RELAXED, __HIP_MEMORY_SCOPE_AGENT); }
__device__ __forceinline__ unsigned xb_add(unsigned* p, unsigned v) { return __hip_atomic_fetch_add(p, v, __ATOMIC_RELAXED, __HIP_MEMORY_SCOPE_AGENT); }
__device__ __forceinline__ unsigned xb_xcc_id() { return (unsigned)__builtin_amdgcn_s_getreg((3 << 11) | 20) & 0xFu; }
#define XB_SPIN(cond, bar) do { unsigned _sp = 0; while (cond) { __builtin_amdgcn_s_sleep(1); \
    if ((++_sp & 255u) == 0u) { if (xb_ld(&(bar)[XB_TMO])) break; if (_sp > XB_SPIN_CAP) { atomicAdd(&(bar)[XB_TMO], 1u); break; } } } } while (0)

struct XcdBarrier {
    unsigned* bar; unsigned x; unsigned wv;
    volatile LAS unsigned* st;
};

__device__ __forceinline__ XcdBarrier xcd_barrier_post(unsigned* bar, volatile LAS unsigned* st) {
    XcdBarrier b; b.bar = bar; b.x = xb_xcc_id(); b.st = st;
    if (threadIdx.x == 0) (void)xb_add(&bar[XB_XCNT(b.x)], 1u);
    return b;
}
__device__ __forceinline__ void xcd_barrier_complete(unsigned* bar, unsigned x, unsigned& nloc, unsigned& nx) {
    const unsigned G = gridDim.x * gridDim.y * gridDim.z;
    unsigned sum, cnt, mine, sp = 0u;
    for (;;) {
        sum = 0u; cnt = 0u; mine = 0u;
#pragma unroll
        for (unsigned j = 0; j < 16; ++j) { const unsigned c = xb_ld(&bar[XB_XCNT(j)]); sum += c; cnt += (c > 0u) ? 1u : 0u; mine = (j == x) ? c : mine; }
        if (sum == G) break;
        __builtin_amdgcn_s_sleep(1);
        if ((++sp & 255u) == 0u) { if (xb_ld(&bar[XB_TMO])) break; if (sp > XB_SPIN_CAP) { atomicAdd(&bar[XB_TMO], 1u); break; } }
    }
    nloc = mine > 0u ? mine : 1u; nx = cnt > 0u ? cnt : 1u;
}

__device__ __forceinline__ void xcd_barrier(const XcdBarrier& b) {
    asm volatile("s_waitcnt vmcnt(0)" ::: "memory");
    __syncthreads();
    if (b.wv == 0 && lane_now() == 0) {
        unsigned* bar = b.bar;
        __builtin_amdgcn_s_waitcnt(0);
        unsigned nloc = b.st[0], nx = b.st[1];
        if (nloc == 0u) { xcd_barrier_complete(bar, b.x, nloc, nx); b.st[0] = nloc; b.st[1] = nx; }
        const unsigned old = xb_add(&bar[XB_XSUB(b.x)], 1u);
        const unsigned gen = old / nloc;
        if (old + 1u == (gen + 1u) * nloc) {
            __builtin_amdgcn_fence(__ATOMIC_RELEASE, "agent");
            asm volatile("s_waitcnt vmcnt(0)" ::: "memory");
            const unsigned og = xb_add(&bar[XB_TOP], 1u);
            const unsigned tg = og / nx;
            if (og + 1u == (tg + 1u) * nx) xb_add(&bar[XB_TOPGEN], 1u);
            else XB_SPIN(xb_ld(&bar[XB_TOPGEN]) == tg, bar);
            __builtin_amdgcn_fence(__ATOMIC_ACQUIRE, "agent");
            xb_add(&bar[XB_XGEN(b.x)], 1u);
            asm volatile("s_waitcnt vmcnt(0)" ::: "memory");
        } else {
            XB_SPIN(xb_ld(&bar[XB_XGEN(b.x)]) == gen, bar);
            __builtin_amdgcn_fence(__ATOMIC_ACQUIRE, "agent");
            asm volatile("s_waitcnt vmcnt(0)" ::: "memory");
        }
    }
    __syncthreads();
}

__global__ void __launch_bounds__(NWAVES * 64, 2) fwd_kernel(Args a) {
    extern __shared__ __attribute__((aligned(16))) unsigned char lds_raw[];
    LAS unsigned char* lds = (LAS unsigned char*)lds_raw;
    if (threadIdx.x < 64) ((LAS unsigned*)(lds + LDS_BAR))[threadIdx.x] = 0u;
    __syncthreads();
    XcdBarrier bar = xcd_barrier_post((unsigned*)(a.ws + WS_BAR), (volatile LAS unsigned*)(lds + LDS_BAR));
    const int wave_sg = __builtin_amdgcn_readfirstlane((int)(threadIdx.x >> 6)); bar.wv = (unsigned)wave_sg;
    for (int ph0 = a.ph_lo; ph0 < a.ph_hi; ++ph0) {
        int ph = ph0; asm volatile("" : "+s"(ph));
        size_t wzero = 0; asm volatile("" : "+s"(wzero)); unsigned char* ws = a.ws + wzero;
        const int wave = wave_sg;
#define lane lane_now()
#define tid (wave_sg * 64 + lane_now())
        const int G = gridDim.x, bx = blockIdx.x, vcu = (G % 8 == 0) ? (bx % 8) * (G / 8) + bx / 8 : bx;
        const int gw = vcu * NWAVES + wave, NGW = G * NWAVES;
        bf16_t* h = (bf16_t*)(ws + WS_H); bf16_t* xb = (bf16_t*)(ws + WS_XB);
        float* stats = (float*)(ws + WS_STATS);
        if (ph == 0) prologue(a, ws, lds, gw, NGW, wave, lane);
        else if (ph == 13) {
            const float* st = stats + (size_t)4 * M * 2; const float* g = a.lng + 3 * D; const float* bb = a.lnb + 3 * D;
            f32x4 gg[4], b4[4];
#pragma unroll
            for (int j = 0; j < 4; ++j) { gg[j] = ((const f32x4*)g)[64 * j + lane]; b4[j] = ((const f32x4*)bb)[64 * j + lane]; }
            for (int m = gw; m < M; m += 4 * NGW) {
                f32x4 v[4][4]; f32x2 sr[4];
#pragma unroll
                for (int r = 0; r < 4; ++r) { sr[r] = *(const f32x2*)(st + 2 * (size_t)(m + r * NGW));
#pragma unroll
                    for (int j = 0; j < 4; ++j) v[r][j] = ((const f32x4*)(a.out + (size_t)(m + r * NGW) * D))[64 * j + lane]; }
#pragma unroll
                for (int r = 0; r < 4; ++r) { const float mu = sr[r].x * INV_D, var = sr[r].y * INV_D - mu * mu, rstd = rsqrtf(var + LN_EPS);
                    f32x4* xr = (f32x4*)(a.out + (size_t)(m + r * NGW) * D) + lane;
#pragma unroll
                    for (int j = 0; j < 4; ++j) xr[64 * j] = (v[r][j] - mu) * rstd * gg[j] + b4[j]; }
            }
        } else if (ph == 1 || (ph - 2) % 3 == 2) {
            const int l = ph == 1 ? 0 : (ph - 2) / 3 + 1;
            if (ph == 1) { pg8::Gemm g{(const bf16_t*)(ws + WS_MEMB), (const bf16_t*)(ws + WS_WKV), BATCH * 256, 4096, D, D}; pg8::StaticOrder S; S.init(BATCH * 256, 4096, G, bx);
                pg8::EpiPlain E{(bf16_t*)(ws + WS_KVMEM), 4096};
                pg8::gemm_phase<pg8::EpiPlain, pg8::StaticOrder, true, true>(lds, g, S, E, tid); }
            pg8::Gemm g{xb, (const bf16_t*)(ws + WS_WIN) + (size_t)l * HP * D, M, HP, D, D}; pg8::StaticOrder S; S.init(M, HP, G, bx);
            pg8::EpiIn E{h, HP, stats + (size_t)l * M * 2, (const float*)(ws + WS_CS) + l * HP, (const float*)(ws + WS_BW) + l * HP};
            pg8::gemm_phase<pg8::EpiIn, pg8::StaticOrder, true, true>(lds, g, S, E, wave_sg * 64 + lane_now());
        } else if ((ph - 2) % 3 == 0) {
            mixer_phase(a, ws, (ph - 2) / 3, lds, gw, NGW, wave, lane);
        } else {
            const int l = (ph - 2) / 3;
            pg8::Gemm g{h, (const bf16_t*)(ws + WS_WOUT) + (size_t)l * D * EB, M, D, EB, HP}; pg8::StaticOrder S; S.init(M, D, G, bx);
            pg8::EpiOut E{l == 0 ? a.x : (l == 3 ? a.out : nullptr), l >= 2 ? a.out : nullptr, xb, stats + (size_t)l * M * 2, stats + (size_t)(l + 1) * M * 2, l ? a.lng + (l - 1) * D : nullptr, l ? a.lnb + (l - 1) * D : nullptr, l < 3 ? 1 : 0};
            pg8::gemm_phase<pg8::EpiOut, pg8::StaticOrder, true, true>(lds, g, S, E, wave_sg * 64 + lane_now());
        }
        if (ph + 1 < a.ph_hi) { if (a.ph_hi > 1000) cg::this_grid().sync();
            { XcdBarrier bb = bar; size_t bz = 0; asm volatile("" : "+s"(bz)); bb.bar = bar.bar + bz; xcd_barrier(bb); } }
    }
#undef lane
#undef tid
}

extern "C" void kernel_launch(void* const* d_in, const int* in_sizes, int n_in, void* d_out, int out_size, void* d_ws, size_t ws_size, hipStream_t stream) {
    static int grid = 0;
    if (grid == 0) {
        if (n_in != 9 || out_size != M * D || ws_size < WS_END) { fprintf(stderr, "kernel_launch: unexpected shapes (n_in %d out %d ws %zu)\n", n_in, out_size, ws_size); grid = -1; return; }
        int dev = 0, cus = 0, per_cu = 0;
        hipGetDevice(&dev); hipDeviceGetAttribute(&cus, hipDeviceAttributeMultiprocessorCount, dev);
        if (hipFuncSetAttribute((const void*)fwd_kernel, hipFuncAttributeMaxDynamicSharedMemorySize, LDS_BYTES) != hipSuccess) { fprintf(stderr, "kernel_launch: hipFuncSetAttribute failed\n"); grid = -1; return; }
        if (hipOccupancyMaxActiveBlocksPerMultiprocessor(&per_cu, (const void*)fwd_kernel, NWAVES * 64, LDS_BYTES) != hipSuccess || per_cu < 1) { fprintf(stderr, "kernel_launch: occupancy query says %d\n", per_cu); per_cu = 1; }
        (void)hipGetLastError();
        grid = cus;
    }
    if (grid < 0) return;
    hipMemsetAsync((char*)d_ws, 0, CTL_BYTES, stream);
    Args a{};
    a.x = (const float*)d_in[0]; a.mem = (const float*)d_in[1]; a.w_in = (const float*)d_in[2]; a.w_kv = (const float*)d_in[3]; a.w_out = (const float*)d_in[4];
    a.rel = (const float*)d_in[5]; a.convw = (const float*)d_in[6]; a.lng = (const float*)d_in[7]; a.lnb = (const float*)d_in[8];
    a.out = (float*)d_out; a.ws = (unsigned char*)d_ws;
#if MK_MULTI
    for (int ph = 0; ph < 14; ++ph) { a.ph_lo = ph; a.ph_hi = ph + 1; hipLaunchKernelGGL(fwd_kernel, dim3(grid), dim3(NWAVES * 64), LDS_BYTES, stream, a); }
#else
    a.ph_lo = 0; a.ph_hi = 14;
    void* args[] = {&a};
    hipError_t e = hipLaunchCooperativeKernel((const void*)fwd_kernel, dim3(grid), dim3(NWAVES * 64), args, LDS_BYTES, stream);
    if (e != hipSuccess) fprintf(stderr, "cooperative launch failed: %s (grid %d)\n", hipGetErrorString(e), grid);
#endif
}
```
